# Optimizing an MI355X kernel written in HIP

```python
import jax, jax.numpy as jnp
from jax import lax
import numpy as np

D_MODEL = 1024
BATCH = 8
SEQ = 2048
DEPTH = 2
DEC_BATCH = 128
DEC_SEQ = 8
PAST_LEN = 16384
PAGE_SIZE = 128

MIX_WIDTH = D_MODEL
POOL_WIDTH = MIX_WIDTH // 2
CONV_WIDTH = MIX_WIDTH - POOL_WIDTH
POOL_WINDOWS = (2, 4, 8, 16)
N_POOL_GROUPS = len(POOL_WINDOWS)
POOL_GC = POOL_WIDTH // N_POOL_GROUPS
POOL_BUF = max(POOL_WINDOWS) - 1
CONV_K = 3
CONV_BUF = CONV_K - 1
N_CONV_HEADS = 8
D_FF = 4 * D_MODEL
PLE_DIM = 256
IN_COLS = POOL_WIDTH + 3 * CONV_WIDTH
EPS = 1e-6

kernel_name = "hybrid_pool_shortconv_decoder_step"


def rmsnorm(x, g):
    xf = x.astype(jnp.float32)
    y = xf * lax.rsqrt(jnp.mean(xf * xf, axis=-1, keepdims=True) + EPS)
    return (y * g.astype(jnp.float32)).astype(x.dtype)


def pool_mixer(u, buf, start, pool_w, pool_scale):
    T = u.shape[1]
    ext = jnp.concatenate([buf, u], axis=1)
    extf = ext.astype(jnp.float32)
    cs = jnp.concatenate([jnp.zeros_like(extf[:, :1]), jnp.cumsum(extf, axis=1)], axis=1)
    pos = start + jnp.arange(T)
    L = POOL_BUF
    outs = []
    for g, w in enumerate(POOL_WINDOWS):
        sl = slice(g * POOL_GC, (g + 1) * POOL_GC)
        win_sum = cs[:, L + 1:L + 1 + T, sl] - cs[:, L + 1 - w:L + 1 - w + T, sl]
        cnt = jnp.minimum(w, pos + 1).astype(jnp.float32)
        d = win_sum / cnt[None, :, None] - extf[:, L:, sl]
        outs.append(jnp.einsum('btc,cd->btd', d.astype(u.dtype), pool_w[g]))
    out = jnp.concatenate(outs, axis=-1) * pool_scale
    return out, ext[:, -L:]


def short_conv(v, buf, w, b):
    T = v.shape[1]
    ext = jnp.concatenate([buf, v], axis=1)
    z = b + sum(w[k] * ext[:, k:k + T] for k in range(CONV_K))
    return z, ext[:, -CONV_BUF:]


def trunk(x, p, pool_bufs, conv_bufs, start,
          norm_mix, w_in, pool_w, pool_scale, conv_w, conv_b, w_out,
          norm_mlp, w_up, w_down, norm_ple, w_ple_gate, w_ple_proj, norm_f):
    h = x
    new_pool, new_conv = [], []
    for i in range(DEPTH):
        a = rmsnorm(h, norm_mix[i])
        proj = jnp.einsum('btd,de->bte', a, w_in[i])
        u = proj[..., :POOL_WIDTH]
        bg = proj[..., POOL_WIDTH:POOL_WIDTH + CONV_WIDTH]
        cg = proj[..., POOL_WIDTH + CONV_WIDTH:POOL_WIDTH + 2 * CONV_WIDTH]
        v = proj[..., POOL_WIDTH + 2 * CONV_WIDTH:]
        y_pool, pb = pool_mixer(u, pool_bufs[i], start, pool_w[i], pool_scale[i])
        z, cb = short_conv(cg * v, conv_bufs[i], conv_w[i], conv_b[i])
        y_conv = bg * z
        mix = jnp.concatenate([y_pool, y_conv], axis=-1)
        h = h + jnp.einsum('btm,md->btd', mix, w_out[i])
        m = rmsnorm(h, norm_mlp[i])
        f = jax.nn.relu(jnp.einsum('btd,df->btf', m, w_up[i]))
        h = h + jnp.einsum('btf,fd->btd', f * f, w_down[i])
        gate = jax.nn.sigmoid(jnp.einsum('btd,de->bte', rmsnorm(h, norm_ple[i]), w_ple_gate[i]))
        h = h + gate * jnp.einsum('btq,qd->btd', p[i], w_ple_proj[i])
        new_pool.append(pb)
        new_conv.append(cb)
    return rmsnorm(h, norm_f), jnp.stack(new_pool), jnp.stack(new_conv)


def setup_inputs(seed: int = 0) -> dict:
    key = jax.random.key(seed)
    ks = jax.random.split(key, 24)
    n = lambda k, s, sc=1.0: jax.random.normal(k, s, jnp.float32) * sc
    return {
        "x_prompt": n(ks[0], (BATCH, SEQ, D_MODEL)),
        "x_sample": n(ks[1], (DEC_BATCH, DEC_SEQ, D_MODEL)),
        "state_pool": n(ks[2], (DEPTH, DEC_BATCH, POOL_BUF, POOL_WIDTH)),
        "state_conv": n(ks[3], (DEPTH, DEC_BATCH, CONV_BUF, CONV_WIDTH)),
        "p_prompt": n(ks[4], (DEPTH, BATCH, SEQ, PLE_DIM)),
        "p_sample": n(ks[5], (DEPTH, DEC_BATCH, DEC_SEQ, PLE_DIM)),
        "norm_mix": 1.0 + n(ks[6], (DEPTH, D_MODEL), 0.05),
        "w_in": n(ks[7], (DEPTH, D_MODEL, IN_COLS), D_MODEL ** -0.5),
        "pool_w": n(ks[8], (DEPTH, N_POOL_GROUPS, POOL_GC, POOL_GC), POOL_GC ** -0.5),
        "pool_scale": 1.0 + n(ks[9], (DEPTH, POOL_WIDTH), 0.1),
        "conv_w": n(ks[10], (DEPTH, CONV_K, CONV_WIDTH), CONV_K ** -0.5),
        "conv_b": n(ks[11], (DEPTH, CONV_WIDTH), 0.02),
        "w_out": n(ks[12], (DEPTH, MIX_WIDTH, D_MODEL), MIX_WIDTH ** -0.5),
        "norm_mlp": 1.0 + n(ks[13], (DEPTH, D_MODEL), 0.05),
        "w_up": n(ks[14], (DEPTH, D_MODEL, D_FF), D_MODEL ** -0.5),
        "w_down": n(ks[15], (DEPTH, D_FF, D_MODEL), D_FF ** -0.5),
        "norm_ple": 1.0 + n(ks[16], (DEPTH, D_MODEL), 0.05),
        "w_ple_gate": n(ks[17], (DEPTH, D_MODEL, D_MODEL), D_MODEL ** -0.5),
        "w_ple_proj": n(ks[18], (DEPTH, PLE_DIM, D_MODEL), PLE_DIM ** -0.5),
        "norm_f": 1.0 + n(ks[19], (D_MODEL,), 0.05),
    }


def reference(x_prompt, x_sample, state_pool, state_conv, p_prompt, p_sample,
              norm_mix, w_in, pool_w, pool_scale, conv_w, conv_b, w_out,
              norm_mlp, w_up, w_down, norm_ple, w_ple_gate, w_ple_proj, norm_f):
    weights = (norm_mix, w_in, pool_w, pool_scale, conv_w, conv_b, w_out,
               norm_mlp, w_up, w_down, norm_ple, w_ple_gate, w_ple_proj, norm_f)
    pool0 = jnp.zeros((DEPTH, x_prompt.shape[0], POOL_BUF, POOL_WIDTH), x_prompt.dtype)
    conv0 = jnp.zeros((DEPTH, x_prompt.shape[0], CONV_BUF, CONV_WIDTH), x_prompt.dtype)
    y_prompt, new_pool_prompt, new_conv_prompt = trunk(x_prompt, p_prompt, pool0, conv0, 0, *weights)
    y_sample, new_pool_sample, new_conv_sample = trunk(x_sample, p_sample, state_pool, state_conv, PAST_LEN, *weights)
    return (y_prompt, y_sample, new_pool_prompt, new_conv_prompt, new_pool_sample, new_conv_sample)
```

```cpp
#include <hip/hip_runtime.h>
#include <cstdio>
#include <cstdint>

#ifndef N_LAUNCH_MODE
#define N_LAUNCH_MODE 1
#endif

#define LAS __attribute__((address_space(3)))
#define GAS __attribute__((address_space(1)))
typedef unsigned short bf16;
typedef short bf16x8 __attribute__((ext_vector_type(8)));
typedef float f32x4 __attribute__((ext_vector_type(4)));
typedef float f32x2 __attribute__((ext_vector_type(2)));
typedef unsigned u32x4 __attribute__((ext_vector_type(4)));
typedef unsigned u32x2 __attribute__((ext_vector_type(2)));

constexpr int D = 1024, SEQ = 2048, NB = 8, DB = 128, DS = 8, DEPTH = 2, PW = 512, CW = 512, DFF = 4096, PLE = 256, INC = 2048;
constexpr int MP = NB * SEQ, MS = DB * DS, MT = MP + MS;
constexpr int NPAN = 64, PR = 272;
constexpr float EPS = 1e-6f;
constexpr int NPHASE = 15;

constexpr size_t O_YP = 0, O_YS = O_YP + (size_t)MP * D, O_NPP = O_YS + (size_t)MS * D, O_NCP = O_NPP + (size_t)DEPTH * NB * 15 * PW,
                 O_NPS = O_NCP + (size_t)DEPTH * NB * 2 * CW, O_NCS = O_NPS + (size_t)DEPTH * DB * 15 * PW, O_END = O_NCS + (size_t)DEPTH * DB * 2 * CW;

constexpr size_t MiB = 1u << 20;
constexpr size_t WS_CTL = 0, CTL_BYTES = 64 * 1024;
constexpr int NSLOT = 32;
constexpr size_t WS_SSQ0 = 1 * MiB, SSQ_BYTES = (size_t)MT * NSLOT * 4;
constexpr size_t WS_SSQ1 = WS_SSQ0 + 2 * MiB + 256 * 1024;
constexpr size_t WS_FOLD = 6 * MiB;
constexpr size_t WS_W = 10 * MiB;
constexpr size_t W_IN = 0, W_OUT = 4 * MiB, W_UP = 6 * MiB, W_DN = 14 * MiB, W_G = 22 * MiB, W_P = 24 * MiB, W_LAYER = 24 * MiB + 512 * 1024;
constexpr size_t WS_HA = WS_W + 2 * W_LAYER;
constexpr size_t WS_PB = WS_HA + 34 * MiB;
constexpr size_t WS_R = WS_PB + 17 * MiB;
constexpr size_t R_PROJ = 0, R_MIX = 68 * MiB, R_HB = 102 * MiB, R_F = 0, R_STASH = 0;
constexpr size_t WS_END = WS_R + 136 * MiB;
static_assert(WS_END <= 256 * MiB, "ws map");
static_assert((size_t)MT * D * 2 == 34 * MiB && (size_t)MT * DFF * 2 == 136 * MiB && (size_t)MT * INC * 2 == 68 * MiB, "sizes");

constexpr int SUBT = 1024;
constexpr int A_SUBS = 34, B_SUBS = 32, STAGE_BYTES = (A_SUBS + B_SUBS) * SUBT;
constexpr int MISC_OFF = 2 * STAGE_BYTES;
constexpr int RSTD_OFF = MISC_OFF + 1024;
constexpr int LDS_BYTES = RSTD_OFF + 1280;

#define VM_WAIT() asm volatile("s_waitcnt vmcnt(0)" ::: "memory")
#define LGKM_WAIT() asm volatile("s_waitcnt lgkmcnt(0)" ::: "memory")
#define LAUNDER_V(x_) asm volatile("" : "+v"(x_))
#define LAUNDER_S(x_) asm volatile("" : "+s"(x_))
#define BAR() do { asm volatile("" ::: "memory"); __builtin_amdgcn_s_barrier(); asm volatile("" ::: "memory"); } while (0)
__device__ __forceinline__ unsigned cvt_pk_bf16(float lo, float hi) { unsigned r; asm volatile("v_cvt_pk_bf16_f32 %0, %1, %2" : "=v"(r) : "v"(lo), "v"(hi)); return r; }
__device__ __forceinline__ float bf_lo(unsigned u) { return __builtin_bit_cast(float, u << 16); }
__device__ __forceinline__ float bf_hi(unsigned u) { return __builtin_bit_cast(float, u & 0xffff0000u); }
__device__ __forceinline__ float wave_sum(float v) {
#pragma unroll
    for (int o = 1; o < 64; o <<= 1) v += __shfl_xor(v, o);
    return v;
}

#define XB_TMO      128
#define XB_XCNT(j)  (256  + 64 * (j))
#define XB_XSUB(j)  (1280 + 64 * (j))
#define XB_XGEN(j)  (2304 + 64 * (j))
#define XB_TOP      3328
#define XB_TOPGEN   3392
#define XCD_BAR_WORDS 3456
#define XB_SPIN_CAP (1u << 18)
__device__ __forceinline__ unsigned xb_ld(unsigned* p)              { return __hip_atomic_load(p, __ATOMIC_RELAXED, __HIP_MEMORY_SCOPE_AGENT); }
__device__ __forceinline__ unsigned xb_add(unsigned* p, unsigned v) { return __hip_atomic_fetch_add(p, v, __ATOMIC_RELAXED, __HIP_MEMORY_SCOPE_AGENT); }
__device__ __forceinline__ unsigned xb_xcc_id() { return (unsigned)__builtin_amdgcn_s_getreg((3 << 11) | 20) & 0xFu; }
#define XB_SPIN(cond, bar) do { unsigned _sp = 0; while (cond) { __builtin_amdgcn_s_sleep(1); \
    if ((++_sp & 255u) == 0u) { if (xb_ld(&(bar)[XB_TMO])) break; if (_sp > XB_SPIN_CAP) { atomicAdd(&(bar)[XB_TMO], 1u); break; } } } } while (0)
struct XcdBarrier { unsigned* bar; unsigned x; volatile LAS unsigned* st; };
__device__ __forceinline__ XcdBarrier xcd_barrier_post(unsigned* bar, volatile LAS unsigned* st) {
    XcdBarrier b; b.bar = bar; b.x = xb_xcc_id(); b.st = st;
    if (threadIdx.x == 0) (void)xb_add(&bar[XB_XCNT(b.x)], 1u);
    return b;
}
__device__ __forceinline__ void xcd_barrier_complete(unsigned* bar, unsigned x, unsigned& nloc, unsigned& nx) {
    const unsigned G = gridDim.x * gridDim.y * gridDim.z;
    unsigned sum, cnt, mine, sp = 0u;
    for (;;) {
        sum = 0u; cnt = 0u; mine = 0u;
#pragma unroll
        for (unsigned j = 0; j < 16; ++j) { const unsigned c = xb_ld(&bar[XB_XCNT(j)]); sum += c; cnt += (c > 0u) ? 1u : 0u; mine = (j == x) ? c : mine; }
        if (sum == G) break;
        __builtin_amdgcn_s_sleep(1);
        if ((++sp & 255u) == 0u) { if (xb_ld(&bar[XB_TMO])) break; if (sp > XB_SPIN_CAP) { atomicAdd(&bar[XB_TMO], 1u); break; } }
    }
    nloc = mine > 0u ? mine : 1u; nx = cnt > 0u ? cnt : 1u;
}
__device__ __forceinline__ void xcd_barrier(const XcdBarrier& b) {
    asm volatile("s_waitcnt vmcnt(0)" ::: "memory");
    __syncthreads();
    if (threadIdx.x == 0) {
        unsigned* bar = b.bar;
        __builtin_amdgcn_s_waitcnt(0);
        unsigned nloc = b.st[0], nx = b.st[1];
        if (nloc == 0u) { xcd_barrier_complete(bar, b.x, nloc, nx); b.st[0] = nloc; b.st[1] = nx; }
        const unsigned old = xb_add(&bar[XB_XSUB(b.x)], 1u);
        const unsigned gen = old / nloc;
        if (old + 1u == (gen + 1u) * nloc) {
            __builtin_amdgcn_fence(__ATOMIC_RELEASE, "agent");
            asm volatile("s_waitcnt vmcnt(0)" ::: "memory");
            const unsigned og = xb_add(&bar[XB_TOP], 1u);
            const unsigned tg = og / nx;
            if (og + 1u == (tg + 1u) * nx) xb_add(&bar[XB_TOPGEN], 1u);
            else XB_SPIN(xb_ld(&bar[XB_TOPGEN]) == tg, bar);
            __builtin_amdgcn_fence(__ATOMIC_ACQUIRE, "agent");
            xb_add(&bar[XB_XGEN(b.x)], 1u);
            asm volatile("s_waitcnt vmcnt(0)" ::: "memory");
        } else {
            XB_SPIN(xb_ld(&bar[XB_XGEN(b.x)]) == gen, bar);
            __builtin_amdgcn_fence(__ATOMIC_ACQUIRE, "agent");
            asm volatile("s_waitcnt vmcnt(0)" ::: "memory");
        }
    }
    __syncthreads();
}

struct Args { const float* in[20]; float* out; unsigned char* ws; int ph_lo, ph_hi; };

struct TileSrc { const unsigned char* a; const unsigned char* b; unsigned lda, ldb; };

#define GLDS16(gp, lp) __builtin_amdgcn_global_load_lds((const unsigned*)(gp), (LAS unsigned*)(lp), 16, 0, 0)

#define ISSUE_TILE(g_, bufoff_) do { \
    const TileSrc ts_ = S.src(g_); \
    unsigned long long ab_ = (unsigned long long)ts_.a, bb_ = (unsigned long long)ts_.b; unsigned lda_ = ts_.lda, ldb_ = ts_.ldb; \
    asm volatile("" : "+s"(ab_), "+s"(bb_), "+s"(lda_), "+s"(ldb_)); \
    const unsigned offA_ = (unsigned)rr * lda_ + (unsigned)cb, offB_ = (unsigned)pr * ldb_ + (unsigned)cb; \
    _Pragma("unroll") for (int i_ = 0; i_ < 4; ++i_) { const int s_ = wave + 8 * i_; \
        GLDS16((const unsigned char*)ab_ + (unsigned)((s_ >> 1) * 16) * lda_ + (unsigned)((s_ & 1) * 64) + offA_, lds + (bufoff_) + s_ * SUBT); } \
    _Pragma("unroll") for (int i_ = 0; i_ < 4; ++i_) { const int s2_ = wave + 8 * i_, G_ = s2_ >> 1; \
        GLDS16((const unsigned char*)bb_ + (unsigned)(64 * (G_ >> 2) + 4 * (G_ & 3)) * ldb_ + (unsigned)((s2_ & 1) * 64) + offB_, lds + (bufoff_) + (A_SUBS + s2_) * SUBT); } \
    if (wave < 2) { GLDS16((const unsigned char*)ab_ + 256u * lda_ + (unsigned)(wave * 64) + offA_, lds + (bufoff_) + (32 + wave) * SUBT); } } while (0)

#define LDA(bufoff_, m_, kk_) (*(const LAS bf16x8*)(lds + (bufoff_) + aoff + (2 * (m_) + (kk_)) * SUBT + rdoff))
#define LDAX(bufoff_, kk_)    (*(const LAS bf16x8*)(lds + (bufoff_) + (32 + (kk_)) * SUBT + rdoff))
#define LDB(bufoff_, n_, kk_) (*(const LAS bf16x8*)(lds + (bufoff_) + boff + (2 * (n_) + (kk_)) * SUBT + rdoff))
#define MFMA(a_, b_, c_) c_ = __builtin_amdgcn_mfma_f32_16x16x32_bf16(b_, a_, c_, 0, 0, 0)

struct Acc { f32x4 m[8][4]; f32x4 x[2]; };
__device__ __forceinline__ void zero_acc(Acc& a) {
#pragma unroll
    for (int m = 0; m < 8; ++m)
#pragma unroll
        for (int n = 0; n < 4; ++n) a.m[m][n] = (f32x4){0.f, 0.f, 0.f, 0.f};
    a.x[0] = (f32x4){0.f, 0.f, 0.f, 0.f}; a.x[1] = (f32x4){0.f, 0.f, 0.f, 0.f};
}

constexpr int PF = 3;

template <class SRC, class POST>
__device__ __forceinline__ void gemm_stream(LAS unsigned char* lds, const SRC& S, POST& P, const int ntot, const int wave_in, const int lane_in) {
    int lane = lane_in; LAUNDER_V(lane); int wave = wave_in; LAUNDER_S(wave);
    const int fr = lane & 15, fq = lane >> 4, wr = wave >> 2, wc = wave & 3;
    const unsigned rdoff = (unsigned)((fr * 64 + fq * 16) ^ ((fr >> 3) << 5));
    const int b16 = lane * 16, swz = b16 ^ (((b16 >> 9) & 1) << 5), rr = swz >> 6, cb = swz & 63, pr = 16 * (rr >> 2) + (rr & 3);
    const unsigned aoff = (unsigned)(16 * wr) * SUBT, boff = (unsigned)(A_SUBS + 8 * wc) * SUBT;
    const bool hi = (wr != 0);
    Acc acc; zero_acc(acc);
    bf16x8 Bp[4], Ap[PF];
    ISSUE_TILE(0, 0);
    VM_WAIT(); BAR();
    if (ntot > 1) ISSUE_TILE(1, STAGE_BYTES);
#pragma unroll
    for (int n = 0; n < 4; ++n) Bp[n] = LDB(0, n, 0);
#pragma unroll
    for (int i = 0; i < PF; ++i) Ap[i] = LDA(0, i, 0);
#pragma unroll 1
    for (int g = 0; g < ntot; ++g) {
        const unsigned cur = (unsigned)(g & 1) * STAGE_BYTES, nxt = STAGE_BYTES - cur;
        {
            bf16x8 a[8];
#pragma unroll
            for (int m = 0; m < 8; ++m) a[m] = (m < PF) ? Ap[m] : LDA(cur, m, 0);
            const bf16x8 ax = LDAX(cur, 0);
#pragma unroll
            for (int m = 0; m < 8; ++m)
#pragma unroll
                for (int n = 0; n < 4; ++n) MFMA(a[m], Bp[n], acc.m[m][n]);
            const bf16x8 bx0 = hi ? Bp[2] : Bp[0], bx1 = hi ? Bp[3] : Bp[1];
            MFMA(ax, bx0, acc.x[0]); MFMA(ax, bx1, acc.x[1]);
        }
        {
            bf16x8 B1[4], a[8];
#pragma unroll
            for (int n = 0; n < 4; ++n) B1[n] = LDB(cur, n, 1);
#pragma unroll
            for (int m = 0; m < 8; ++m) a[m] = LDA(cur, m, 1);
            const bf16x8 ax = LDAX(cur, 1);
#pragma unroll
            for (int m = 0; m < 5; ++m)
#pragma unroll
                for (int n = 0; n < 4; ++n) MFMA(a[m], B1[n], acc.m[m][n]);
            LGKM_WAIT(); VM_WAIT(); BAR();
            if (g + 2 < ntot) ISSUE_TILE(g + 2, cur);
#pragma unroll
            for (int n = 0; n < 4; ++n) Bp[n] = LDB(nxt, n, 0);
#pragma unroll
            for (int i = 0; i < PF; ++i) Ap[i] = LDA(nxt, i, 0);
#pragma unroll
            for (int m = 5; m < 8; ++m)
#pragma unroll
                for (int n = 0; n < 4; ++n) MFMA(a[m], B1[n], acc.m[m][n]);
            const bf16x8 bx0 = hi ? B1[2] : B1[0], bx1 = hi ? B1[3] : B1[1];
            MFMA(ax, bx0, acc.x[0]); MFMA(ax, bx1, acc.x[1]);
        }
        P(g, acc, wr, wc, fr, fq);
    }
    LGKM_WAIT(); VM_WAIT(); BAR();
}

__device__ __forceinline__ void panel_rstd(LAS unsigned char* lds, const float* ssq, int pm, int tid) {
    LAS float* rt = (LAS float*)(lds + RSTD_OFF);
    if (tid < PR) {
        const GAS f32x4* p = (const GAS f32x4*)(ssq + (size_t)(pm * PR + tid) * NSLOT);
        float s = 0.f;
#pragma unroll
        for (int i = 0; i < NSLOT / 4; ++i) { const f32x4 q = p[i]; s += (q.x + q.y) + (q.z + q.w); }
        rt[tid] = __builtin_amdgcn_rsqf(s * (1.0f / D) + EPS);
    }
    __syncthreads();
}
#define RSTD(r_) (((const LAS float*)(lds + RSTD_OFF))[r_])
__device__ __forceinline__ void store16(bf16* p, const float (&v)[16]) {
    u32x4 a, b;
    a.x = cvt_pk_bf16(v[0], v[1]); a.y = cvt_pk_bf16(v[2], v[3]); a.z = cvt_pk_bf16(v[4], v[5]); a.w = cvt_pk_bf16(v[6], v[7]);
    b.x = cvt_pk_bf16(v[8], v[9]); b.y = cvt_pk_bf16(v[10], v[11]); b.z = cvt_pk_bf16(v[12], v[13]); b.w = cvt_pk_bf16(v[14], v[15]);
    *(GAS u32x4*)p = a; *(GAS u32x4*)(p + 8) = b;
}
__device__ __forceinline__ void store8(bf16* p, const float (&v)[8]) {
    u32x4 a;
    a.x = cvt_pk_bf16(v[0], v[1]); a.y = cvt_pk_bf16(v[2], v[3]); a.z = cvt_pk_bf16(v[4], v[5]); a.w = cvt_pk_bf16(v[6], v[7]);
    *(GAS u32x4*)p = a;
}
__device__ __forceinline__ void load16(const bf16* p, float (&v)[16]) {
    const u32x4 a = *(const GAS u32x4*)p, b = *(const GAS u32x4*)(p + 8);
    v[0] = bf_lo(a.x); v[1] = bf_hi(a.x); v[2] = bf_lo(a.y); v[3] = bf_hi(a.y); v[4] = bf_lo(a.z); v[5] = bf_hi(a.z); v[6] = bf_lo(a.w); v[7] = bf_hi(a.w);
    v[8] = bf_lo(b.x); v[9] = bf_hi(b.x); v[10] = bf_lo(b.y); v[11] = bf_hi(b.y); v[12] = bf_lo(b.z); v[13] = bf_hi(b.z); v[14] = bf_lo(b.w); v[15] = bf_hi(b.w);
}
__device__ __forceinline__ void load8(const bf16* p, float (&v)[8]) {
    const u32x4 a = *(const GAS u32x4*)p;
    v[0] = bf_lo(a.x); v[1] = bf_hi(a.x); v[2] = bf_lo(a.y); v[3] = bf_hi(a.y); v[4] = bf_lo(a.z); v[5] = bf_hi(a.z); v[6] = bf_lo(a.w); v[7] = bf_hi(a.w);
}

struct SrcPlain {
    const unsigned char* A; const unsigned char* B; unsigned lda, ldb; int nt, pn0;
    __device__ __forceinline__ TileSrc src(int g) const { const int u = g / nt, t = g - u * nt;
        TileSrc r; r.a = A + (size_t)t * 128; r.b = B + (size_t)(pn0 + u) * 256 * ldb + (size_t)t * 128; r.lda = lda; r.ldb = ldb; return r; }
};
struct SrcPle {
    const unsigned char* Ap; const unsigned char* Bp; const unsigned char* Ah; const unsigned char* Bg;
    __device__ __forceinline__ TileSrc src(int g) const { TileSrc r;
        if (g < 4) { r.a = Ap + (size_t)g * 128; r.b = Bp + (size_t)g * 128; r.lda = PLE * 2; r.ldb = PLE * 2; }
        else { r.a = Ah + (size_t)(g - 4) * 128; r.b = Bg + (size_t)(g - 4) * 128; r.lda = D * 2; r.ldb = D * 2; }
        return r; }
};

template <int ACT>
struct PostScale {
    LAS unsigned char* lds; bf16* out; int ldo, pm, pn0, nt, tc, u;
    static __device__ __forceinline__ float act(float x) { if (ACT == 1) { x = fmaxf(x, 0.f); x = x * x; } return x; }
    __device__ __forceinline__ void operator()(int, Acc& acc, int wr, int wc, int fr, int fq) {
        if (++tc < nt) return; tc = 0;
        int lr0 = 128 * wr + fr; LAUNDER_V(lr0);
        const unsigned eoff0 = (unsigned)(pm * PR + lr0) * (unsigned)ldo + (unsigned)((pn0 + u) * 256 + 64 * wc + 16 * fq);
        GAS unsigned char* ob = (GAS unsigned char*)out;
#pragma unroll
        for (int m = 0; m < 8; ++m) { const float rs = RSTD(lr0 + 16 * m);
            float v[16];
#pragma unroll
            for (int k = 0; k < 16; ++k) v[k] = act(acc.m[m][k >> 2][k & 3] * rs);
            store16((bf16*)(ob + 2u * (eoff0 + (unsigned)(16 * m) * (unsigned)ldo)), v); }
        { int lrx = 256 + fr; LAUNDER_V(lrx); const float rs = RSTD(lrx);
            const unsigned eoffx = (unsigned)(pm * PR + lrx) * (unsigned)ldo + (unsigned)((pn0 + u) * 256 + 64 * wc + 16 * fq + 8 * wr);
            float v[8];
#pragma unroll
            for (int k = 0; k < 8; ++k) v[k] = act(acc.x[k >> 2][k & 3] * rs);
            store8((bf16*)(ob + 2u * eoffx), v); }
        zero_acc(acc); ++u;
    }
};
struct PostRes {
    const bf16* hin; bf16* hout; float* ssq_out; int pm, pn, nt, tc;
    __device__ __forceinline__ void operator()(int, Acc& acc, int wr, int wc, int fr, int fq) {
        if (++tc < nt) return; tc = 0;
        int row0 = pm * PR + 128 * wr + fr; LAUNDER_V(row0);
        const unsigned eoff0 = (unsigned)row0 * D + (unsigned)(pn * 256 + 64 * wc + 16 * fq);
        const GAS unsigned char* ib = (const GAS unsigned char*)hin; GAS unsigned char* ob = (GAS unsigned char*)hout;
#pragma unroll
        for (int m = 0; m < 8; ++m) { const unsigned eo = 2u * (eoff0 + (unsigned)(16 * m * D));
            float v[16]; load16((const bf16*)(ib + eo), v); float ss = 0.f;
#pragma unroll
            for (int k = 0; k < 16; ++k) { v[k] += acc.m[m][k >> 2][k & 3]; ss += v[k] * v[k]; }
            store16((bf16*)(ob + eo), v);
            ss += __shfl_xor(ss, 16); ss += __shfl_xor(ss, 32);
            if (fq == 0) *(GAS f32x2*)(ssq_out + (unsigned)(row0 + 16 * m) * NSLOT + 8 * pn + 2 * wc) = (f32x2){ss, 0.f}; }
        { int rowx = pm * PR + 256 + fr; LAUNDER_V(rowx);
            const unsigned eo = 2u * ((unsigned)rowx * D + (unsigned)(pn * 256 + 64 * wc + 16 * fq + 8 * wr));
            float v[8]; load8((const bf16*)(ib + eo), v); float ss = 0.f;
#pragma unroll
            for (int k = 0; k < 8; ++k) { v[k] += acc.x[k >> 2][k & 3]; ss += v[k] * v[k]; }
            store8((bf16*)(ob + eo), v);
            ss += __shfl_xor(ss, 16); ss += __shfl_xor(ss, 32);
            if (fq == 0) ssq_out[(unsigned)rowx * NSLOT + 8 * pn + 2 * wc + wr] = ss; }
        zero_acc(acc);
    }
};
struct PostPle {
    LAS unsigned char* lds; const bf16* hin; bf16* hout; float* ssq_out; float* stash; int pm, pn;
    __device__ __forceinline__ void operator()(int g, Acc& acc, int wr, int wc, int fr, int fq) {
        if (g != 3 && g != 19) return;
        int tid = (wr * 4 + wc) * 64 + fq * 16 + fr; LAUNDER_V(tid);
        GAS f32x4* st = (GAS f32x4*)stash + tid;
        if (g == 3) {
#pragma unroll
            for (int m = 0; m < 8; ++m)
#pragma unroll
                for (int n = 0; n < 4; ++n) st[(m * 4 + n) * 512] = acc.m[m][n];
            st[32 * 512] = acc.x[0]; st[33 * 512] = acc.x[1];
            zero_acc(acc);
        } else {
            int lr0 = 128 * wr + fr; LAUNDER_V(lr0);
            const int row0 = pm * PR + lr0;
            const unsigned eoff0 = (unsigned)row0 * D + (unsigned)(pn * 256 + 64 * wc + 16 * fq);
            const GAS unsigned char* ib = (const GAS unsigned char*)hin; GAS unsigned char* ob = (GAS unsigned char*)hout;
#pragma unroll
            for (int m = 0; m < 8; ++m) { const float rs = RSTD(lr0 + 16 * m); const unsigned eo = 2u * (eoff0 + (unsigned)(16 * m * D));
                float v[16]; load16((const bf16*)(ib + eo), v); float ss = 0.f;
#pragma unroll
                for (int n = 0; n < 4; ++n) { const f32x4 pp = st[(m * 4 + n) * 512];
#pragma unroll
                    for (int j = 0; j < 4; ++j) { const float gt = 1.0f / (1.0f + __expf(-acc.m[m][n][j] * rs)); const int k = 4 * n + j; v[k] += gt * pp[j]; ss += v[k] * v[k]; } }
                store16((bf16*)(ob + eo), v);
                ss += __shfl_xor(ss, 16); ss += __shfl_xor(ss, 32);
                if (fq == 0) *(GAS f32x2*)(ssq_out + (unsigned)(row0 + 16 * m) * NSLOT + 8 * pn + 2 * wc) = (f32x2){ss, 0.f}; }
            { int lrx = 256 + fr; LAUNDER_V(lrx); const int rowx = pm * PR + lrx; const float rs = RSTD(lrx);
                const unsigned eo = 2u * ((unsigned)rowx * D + (unsigned)(pn * 256 + 64 * wc + 16 * fq + 8 * wr));
                float v[8]; load8((const bf16*)(ib + eo), v); float ss = 0.f;
#pragma unroll
                for (int n = 0; n < 2; ++n) { const f32x4 pp = st[(32 + n) * 512];
#pragma unroll
                    for (int j = 0; j < 4; ++j) { const float gt = 1.0f / (1.0f + __expf(-acc.x[n][j] * rs)); const int k = 4 * n + j; v[k] += gt * pp[j]; ss += v[k] * v[k]; } }
                store8((bf16*)(ob + eo), v);
                ss += __shfl_xor(ss, 16); ss += __shfl_xor(ss, 32);
                if (fq == 0) ssq_out[(unsigned)rowx * NSLOT + 8 * pn + 2 * wc + wr] = ss; }
        }
    }
};

__device__ __forceinline__ const float* x_row(const float* xp, const float* xs, int R) { const int pm = R / PR, i = R - pm * PR;
    return i < 256 ? xp + (size_t)(256 * pm + i) * D : xs + (size_t)(16 * pm + i - 256) * D; }

__device__ __forceinline__ void transpose_item(const float* W, int ldw, const float* gain, bf16* WT, int K, int k0, int n0, LAS float* scr, int lane) {
#pragma unroll 8
    for (int i = 0; i < 32; ++i) { const int kk = 2 * i + (lane >> 5); float v = W[(size_t)(k0 + kk) * ldw + n0 + (lane & 31)]; if (gain) v *= gain[k0 + kk]; scr[kk * 33 + (lane & 31)] = v; }
    LGKM_WAIT(); asm volatile("" ::: "memory");
    const int c = lane & 7;
#pragma unroll
    for (int j = 0; j < 4; ++j) { const int n = (lane >> 3) + 8 * j; const LAS float* s = scr + (8 * c) * 33 + n;
        u32x4 o; o.x = cvt_pk_bf16(s[0 * 33], s[1 * 33]); o.y = cvt_pk_bf16(s[2 * 33], s[3 * 33]); o.z = cvt_pk_bf16(s[4 * 33], s[5 * 33]); o.w = cvt_pk_bf16(s[6 * 33], s[7 * 33]);
        *(GAS u32x4*)(WT + (size_t)(n0 + n) * K + k0 + 8 * c) = o; }
    LGKM_WAIT(); asm volatile("" ::: "memory");
}

__device__ __forceinline__ f32x2 ld_bf2(const bf16* p) { const unsigned u = *(const GAS unsigned*)p; return (f32x2){bf_lo(u), bf_hi(u)}; }
__device__ __forceinline__ void st_bf2(bf16* p, f32x2 v) { *(GAS unsigned*)p = cvt_pk_bf16(v.x, v.y); }

struct MixCtx { const bf16* proj; bf16* mix; const float* state_pool; const float* state_conv; const float* conv_w; const float* conv_b;
                float* npp; float* ncp; float* nps; float* ncs; int layer; };

#define PJ(off_) ld_bf2((const bf16*)(pbase + (off_)))
template <int W>
__device__ __forceinline__ void mix_prompt_strip(const MixCtx& M, int pm, int s, int tl) {
    int c = 2 * tl; LAUNDER_V(c);
    const int b = pm >> 3, t0 = (pm & 7) * 256 + 32 * s, R0 = pm * PR + 32 * s;
    const int Rh = (s > 0) ? R0 : (pm - 1) * PR + 256;
    const bool first = (t0 == 0), last = ((pm & 7) == 7 && s == 7);
    const int layer = M.layer;
    const GAS unsigned char* pbase = (const GAS unsigned char*)M.proj; GAS unsigned char* mbase = (GAS unsigned char*)M.mix;
    const unsigned po = (unsigned)R0 * (INC * 2) + 2u * c, mo = (unsigned)R0 * (D * 2) + 2u * c, ho = (unsigned)Rh * (INC * 2) + 2u * c;
    {
        f32x2 ring[16]; f32x2 S = (f32x2){0.f, 0.f};
#pragma unroll
        for (int j = W - 1; j >= 1; --j) { f32x2 v = (f32x2){0.f, 0.f}; if (!first) v = PJ(ho - (unsigned)(j * INC * 2)); ring[(16 - j) & 15] = v; S += v; }
#pragma unroll
        for (int hb = 0; hb < 2; ++hb) {
            f32x2 u[16];
#pragma unroll
            for (int r = 0; r < 16; ++r) u[r] = PJ(po + (unsigned)((16 * hb + r) * INC * 2));
#pragma unroll
            for (int r = 0; r < 16; ++r) { const int rr_ = 16 * hb + r;
                S += u[r];
                const int cnt = (t0 + rr_ + 1) < W ? (t0 + rr_ + 1) : W;
                const f32x2 d = S * (1.0f / (float)cnt) - u[r];
                *(GAS unsigned*)(mbase + mo + (unsigned)(rr_ * D * 2)) = cvt_pk_bf16(d.x, d.y);
                if (last && rr_ >= 17) *(GAS f32x2*)(M.npp + ((size_t)(layer * NB + b) * 15 + (rr_ - 17)) * PW + c) = u[r];
                ring[rr_ & 15] = u[r];
                S -= ring[(rr_ - W + 1) & 15];
            }
        }
    }
    {
        f32x2 cm2 = (f32x2){0.f, 0.f}, cm1 = (f32x2){0.f, 0.f};
        if (!first) { cm2 = PJ(ho - 2u * (INC * 2) + 2048u) * PJ(ho - 2u * (INC * 2) + 3072u);
                      cm1 = PJ(ho - 1u * (INC * 2) + 2048u) * PJ(ho - 1u * (INC * 2) + 3072u); }
        const f32x2 w0 = *(const GAS f32x2*)(M.conv_w + (size_t)(layer * 3 + 0) * CW + c), w1 = *(const GAS f32x2*)(M.conv_w + (size_t)(layer * 3 + 1) * CW + c),
                    w2 = *(const GAS f32x2*)(M.conv_w + (size_t)(layer * 3 + 2) * CW + c), bias = *(const GAS f32x2*)(M.conv_b + (size_t)layer * CW + c);
#pragma unroll
        for (int hb = 0; hb < 4; ++hb) {
            f32x2 bgv[8], ccv[8];
#pragma unroll
            for (int r = 0; r < 8; ++r) { const unsigned o = po + (unsigned)((8 * hb + r) * INC * 2); bgv[r] = PJ(o + 1024u); ccv[r] = PJ(o + 2048u) * PJ(o + 3072u); }
#pragma unroll
            for (int r = 0; r < 8; ++r) { const int rr_ = 8 * hb + r;
                const f32x2 z = bias + w0 * cm2 + w1 * cm1 + w2 * ccv[r]; const f32x2 y = bgv[r] * z;
                *(GAS unsigned*)(mbase + mo + 1024u + (unsigned)(rr_ * D * 2)) = cvt_pk_bf16(y.x, y.y);
                if (last && rr_ >= 30) *(GAS f32x2*)(M.ncp + ((size_t)(layer * NB + b) * 2 + (rr_ - 30)) * CW + c) = ccv[r];
                cm2 = cm1; cm1 = ccv[r]; }
        }
    }
}
template <int W>
__device__ __forceinline__ void mix_sample_seq(const MixCtx& M, int pm, int q, int tl) {
    const int c = 2 * tl, b = 2 * pm + q, R0 = pm * PR + 256 + 8 * q; const int layer = M.layer;
    const float* sp = M.state_pool + (size_t)(layer * DB + b) * 15 * PW + c;
    float* nps = M.nps + (size_t)(layer * DB + b) * 15 * PW + c;
    {
        f32x2 ring[16]; f32x2 S = (f32x2){0.f, 0.f};
#pragma unroll
        for (int j = W - 1; j >= 1; --j) { const f32x2 v = *(const GAS f32x2*)(sp + (size_t)(15 - j) * PW); ring[(16 - j) & 15] = v; S += v; }
#pragma unroll
        for (int r = 0; r < 8; ++r) {
            const f32x2 u = ld_bf2(M.proj + (size_t)(R0 + r) * INC + c);
            S += u;
            const f32x2 d = S * (1.0f / (float)W) - u;
            st_bf2(M.mix + (size_t)(R0 + r) * D + c, d);
            *(GAS f32x2*)(nps + (size_t)(7 + r) * PW) = u;
            ring[r & 15] = u;
            S -= ring[(r - W + 1) & 15];
        }
#pragma unroll
        for (int i = 0; i < 7; ++i) *(GAS f32x2*)(nps + (size_t)i * PW) = *(const GAS f32x2*)(sp + (size_t)(8 + i) * PW);
    }
    {
        const float* sc = M.state_conv + (size_t)(layer * DB + b) * 2 * CW + c;
        f32x2 cm2 = *(const GAS f32x2*)(sc), cm1 = *(const GAS f32x2*)(sc + CW);
        const f32x2 w0 = *(const GAS f32x2*)(M.conv_w + (size_t)(layer * 3 + 0) * CW + c), w1 = *(const GAS f32x2*)(M.conv_w + (size_t)(layer * 3 + 1) * CW + c),
                    w2 = *(const GAS f32x2*)(M.conv_w + (size_t)(layer * 3 + 2) * CW + c), bias = *(const GAS f32x2*)(M.conv_b + (size_t)layer * CW + c);
#pragma unroll
        for (int r = 0; r < 8; ++r) { const bf16* p = M.proj + (size_t)(R0 + r) * INC + c;
            const f32x2 bgv = ld_bf2(p + 512), ccv = ld_bf2(p + 1024) * ld_bf2(p + 1536);
            const f32x2 z = bias + w0 * cm2 + w1 * cm1 + w2 * ccv;
            st_bf2(M.mix + (size_t)(R0 + r) * D + 512 + c, bgv * z);
            if (r >= 6) *(GAS f32x2*)(M.ncs + ((size_t)(layer * DB + b) * 2 + (r - 6)) * CW + c) = ccv;
            cm2 = cm1; cm1 = ccv; }
    }
}
template <int W>
__device__ __forceinline__ void mix_block(const MixCtx& M, int pm, int q, int half, int tl) {
    mix_prompt_strip<W>(M, pm, 2 * q + half, tl);
    if (q < 2 && half == 0) mix_sample_seq<W>(M, pm, q, tl);
}

__global__ void __launch_bounds__(512) fwd_kernel(Args args) {
    extern __shared__ __attribute__((aligned(16))) unsigned char lds_raw[];
    LAS unsigned char* lds = (LAS unsigned char*)lds_raw;
    const int tid = threadIdx.x, lane = tid & 63, wave = __builtin_amdgcn_readfirstlane(tid >> 6);
    const int G = gridDim.x, bx = blockIdx.x, vcu = (G % 8 == 0) ? (bx % 8) * (G / 8) + bx / 8 : bx;
    const int pm_ = vcu >> 2, q_ = vcu & 3;
    unsigned char* ws = args.ws;
    const int lo = args.ph_lo, hi = args.ph_hi;

    volatile LAS unsigned* MISC = (volatile LAS unsigned*)(lds + MISC_OFF);
    if (tid < 64) MISC[tid] = 0u;
    __syncthreads();
    XcdBarrier bar; bar.bar = (unsigned*)(ws + WS_CTL); bar.x = 0; bar.st = MISC;
    if (hi - lo > 1) bar = xcd_barrier_post((unsigned*)(ws + WS_CTL), MISC);
#ifndef PH_EN
#define PH_EN 0x7fff
#endif
#define LY_EN(i) ((PH_EN >> (2 + (i))) & 1)
#define IN(k) (lo <= (k) && (k) < hi)
#define SEAM(k) do { if (IN(k) && IN((k) + 1)) xcd_barrier(bar); } while (0)

    const float* x_prompt = args.in[0]; const float* x_sample = args.in[1]; const float* state_pool = args.in[2]; const float* state_conv = args.in[3];
    const float* p_prompt = args.in[4]; const float* p_sample = args.in[5]; const float* norm_mix = args.in[6]; const float* w_in = args.in[7];
    const float* pool_w = args.in[8]; const float* pool_scale = args.in[9]; const float* conv_w = args.in[10]; const float* conv_b = args.in[11];
    const float* w_out = args.in[12]; const float* norm_mlp = args.in[13]; const float* w_up = args.in[14]; const float* w_down = args.in[15];
    const float* norm_ple = args.in[16]; const float* w_ple_gate = args.in[17]; const float* w_ple_proj = args.in[18]; const float* norm_f = args.in[19];
    float* out = args.out;
    float* ssq0 = (float*)(ws + WS_SSQ0); float* ssq1 = (float*)(ws + WS_SSQ1);
    float* fold = (float*)(ws + WS_FOLD);
    bf16* hA = (bf16*)(ws + WS_HA); bf16* hB = (bf16*)(ws + WS_R + R_HB);
    bf16* pb = (bf16*)(ws + WS_PB);
    bf16* proj = (bf16*)(ws + WS_R + R_PROJ); bf16* mixA = (bf16*)(ws + WS_R + R_MIX); bf16* fbuf = (bf16*)(ws + WS_R + R_F);
    float* stash = (float*)(ws + WS_R + R_STASH) + (size_t)bx * (PR * 256);
    const int gw = vcu * 8 + wave, NGW = G * 8;

    if ((PH_EN & 1) && IN(0)) {
        for (int R = gw; R < MT; R += NGW) {
            const GAS f32x4* xr = (const GAS f32x4*)x_row(x_prompt, x_sample, R) + lane;
            f32x4 v[4]; float s = 0.f;
#pragma unroll
            for (int j = 0; j < 4; ++j) { v[j] = xr[64 * j]; s += (v[j].x * v[j].x + v[j].y * v[j].y) + (v[j].z * v[j].z + v[j].w * v[j].w); }
            s = wave_sum(s);
            GAS u32x2* o = (GAS u32x2*)(hA + (size_t)R * D) + lane;
#pragma unroll
            for (int j = 0; j < 4; ++j) o[64 * j] = (u32x2){cvt_pk_bf16(v[j].x, v[j].y), cvt_pk_bf16(v[j].z, v[j].w)};
            if (lane < NSLOT) ssq0[(size_t)R * NSLOT + lane] = (lane == 0) ? s : 0.f;
        }
        for (int idx = gw; idx < 2 * MT; idx += NGW) {
            const int l = idx / MT, R = idx - l * MT, pmr = R / PR, i = R - pmr * PR;
            const float* src = i < 256 ? p_prompt + ((size_t)l * MP + 256 * pmr + i) * PLE : p_sample + ((size_t)l * MS + 16 * pmr + i - 256) * PLE;
            const f32x4 v = ((const GAS f32x4*)src)[lane];
            ((GAS u32x2*)(pb + (size_t)idx * PLE))[lane] = (u32x2){cvt_pk_bf16(v.x, v.y), cvt_pk_bf16(v.z, v.w)};
        }
        for (int o = vcu * 512 + tid; o < DEPTH * 512 * D; o += G * 512) {
            const int l = o >> 19, k = (o >> 10) & 511, n = o & 1023, g = k >> 7, kl = k & 127;
            const float* pw = pool_w + ((size_t)(l * 4 + g) * 128 + kl) * 128; const float* sc = pool_scale + l * PW + 128 * g; const float* wo = w_out + ((size_t)l * D + 128 * g) * D + n;
            float a = 0.f;
#pragma unroll 8
            for (int c = 0; c < 128; ++c) a += pw[c] * sc[c] * wo[(size_t)c * D];
            fold[o] = a;
        }
    }
    SEAM(0);
    if ((PH_EN & 2) && IN(1)) {
        LAS float* scr = (LAS float*)(lds + wave * 16384);
        constexpr int I_IN = 16 * 64, I_OUT = 16 * 32, I_UP = 16 * 128, I_DN = 64 * 32, I_G = 16 * 32, I_P = 4 * 32, I_L = I_IN + I_OUT + I_UP + I_DN + I_G + I_P;
        for (int it = gw; it < DEPTH * I_L; it += NGW) {
            const int l = it / I_L; int r = it - l * I_L; unsigned char* wl = ws + WS_W + (size_t)l * W_LAYER;
            if (r < I_IN) { const int kb = r / 64, nb = r % 64; transpose_item(w_in + (size_t)l * D * INC, INC, norm_mix + l * D, (bf16*)(wl + W_IN), D, 64 * kb, 32 * nb, scr, lane); continue; } r -= I_IN;
            if (r < I_OUT) { const int kb = r / 32, nb = r % 32; const float* srcw = (kb < 8) ? fold + (size_t)l * 512 * D : w_out + (size_t)l * D * D;
                transpose_item(srcw, D, nullptr, (bf16*)(wl + W_OUT), D, 64 * kb, 32 * nb, scr, lane); continue; } r -= I_OUT;
            if (r < I_UP) { const int kb = r / 128, nb = r % 128; transpose_item(w_up + (size_t)l * D * DFF, DFF, norm_mlp + l * D, (bf16*)(wl + W_UP), D, 64 * kb, 32 * nb, scr, lane); continue; } r -= I_UP;
            if (r < I_DN) { const int kb = r / 32, nb = r % 32; transpose_item(w_down + (size_t)l * DFF * D, D, nullptr, (bf16*)(wl + W_DN), DFF, 64 * kb, 32 * nb, scr, lane); continue; } r -= I_DN;
            if (r < I_G) { const int kb = r / 32, nb = r % 32; transpose_item(w_ple_gate + (size_t)l * D * D, D, norm_ple + l * D, (bf16*)(wl + W_G), D, 64 * kb, 32 * nb, scr, lane); continue; } r -= I_G;
            { const int kb = r / 32, nb = r % 32; transpose_item(w_ple_proj + (size_t)l * PLE * D, D, nullptr, (bf16*)(wl + W_P), PLE, 64 * kb, 32 * nb, scr, lane); }
        }
        __syncthreads();
    }
    SEAM(1);

#pragma unroll 1
    for (int l = 0; l < DEPTH; ++l) {
        const int p0 = 2 + 6 * l;
        int pm = pm_; int q = q_;
        const unsigned char* wl = ws + WS_W + (size_t)l * W_LAYER;
        const bf16* hin = (l == 0) ? hA : hB;
        float* ssA = (l == 0) ? ssq0 : ssq1;
        float* ssB = (l == 0) ? ssq1 : ssq0;
        if (LY_EN(0) && IN(p0 + 0)) { LAUNDER_S(pm); LAUNDER_S(q);
            SrcPlain S{(const unsigned char*)(hin + (size_t)pm * PR * D), wl + W_IN, D * 2, D * 2, 16, 2 * q};
            panel_rstd(lds, ssA, pm, tid);
            PostScale<0> P{lds, proj, INC, pm, 2 * q, 16, 0, 0};
            gemm_stream(lds, S, P, 32, wave, lane);
        }
        SEAM(p0 + 0);
        if (LY_EN(1) && IN(p0 + 1)) { LAUNDER_S(pm); LAUNDER_S(q);
            MixCtx M{proj, mixA, state_pool, state_conv, conv_w, conv_b, out + O_NPP, out + O_NCP, out + O_NPS, out + O_NCS, l};
            const int half = wave >> 2, tl = tid & 255, wsel = wave & 3;
            if (wsel == 0) mix_block<2>(M, pm, q, half, tl); else if (wsel == 1) mix_block<4>(M, pm, q, half, tl);
            else if (wsel == 2) mix_block<8>(M, pm, q, half, tl); else mix_block<16>(M, pm, q, half, tl);
        }
        SEAM(p0 + 1);
        if (LY_EN(2) && IN(p0 + 2)) { LAUNDER_S(pm); LAUNDER_S(q);
            SrcPlain S{(const unsigned char*)(mixA + (size_t)pm * PR * D), wl + W_OUT, D * 2, D * 2, 16, q};
            PostRes P{hin, hA, ssB, pm, q, 16, 0};
            gemm_stream(lds, S, P, 16, wave, lane);
        }
        SEAM(p0 + 2);
        if (LY_EN(3) && IN(p0 + 3)) { LAUNDER_S(pm); LAUNDER_S(q);
            SrcPlain S{(const unsigned char*)(hA + (size_t)pm * PR * D), wl + W_UP, D * 2, D * 2, 16, 4 * q};
            panel_rstd(lds, ssB, pm, tid);
            PostScale<1> P{lds, fbuf, DFF, pm, 4 * q, 16, 0, 0};
            gemm_stream(lds, S, P, 64, wave, lane);
        }
        SEAM(p0 + 3);
        if (LY_EN(4) && IN(p0 + 4)) { LAUNDER_S(pm); LAUNDER_S(q);
            SrcPlain S{(const unsigned char*)(fbuf + (size_t)pm * PR * DFF), wl + W_DN, DFF * 2, DFF * 2, 64, q};
            PostRes P{hA, hA, ssA, pm, q, 64, 0};
            gemm_stream(lds, S, P, 64, wave, lane);
        }
        SEAM(p0 + 4);
        if (LY_EN(5) && IN(p0 + 5)) { LAUNDER_S(pm); LAUNDER_S(q);
            SrcPle S{(const unsigned char*)(pb + ((size_t)l * MT + (size_t)pm * PR) * PLE), wl + W_P + (size_t)q * 256 * PLE * 2,
                     (const unsigned char*)(hA + (size_t)pm * PR * D), wl + W_G + (size_t)q * 256 * D * 2};
            panel_rstd(lds, ssA, pm, tid);
            PostPle P{lds, hA, hB, ssB, stash, pm, q};
            gemm_stream(lds, S, P, 20, wave, lane);
        }
        SEAM(p0 + 5);
    }
    if ((PH_EN & 0x4000) && IN(14)) {
        f32x4 gv[4];
#pragma unroll
        for (int j = 0; j < 4; ++j) gv[j] = ((const GAS f32x4*)norm_f)[lane * 2 + (j & 1) + 128 * (j >> 1)];
        for (int R = gw; R < MT; R += NGW) {
            const int pmr = R / PR, i = R - pmr * PR;
            float* dst = i < 256 ? out + O_YP + (size_t)(256 * pmr + i) * D : out + O_YS + (size_t)(16 * pmr + i - 256) * D;
            const GAS u32x4* hr = (const GAS u32x4*)(hB + (size_t)R * D);
            const u32x4 a = hr[lane], b = hr[64 + lane];
            float v[16] = {bf_lo(a.x), bf_hi(a.x), bf_lo(a.y), bf_hi(a.y), bf_lo(a.z), bf_hi(a.z), bf_lo(a.w), bf_hi(a.w),
                           bf_lo(b.x), bf_hi(b.x), bf_lo(b.y), bf_hi(b.y), bf_lo(b.z), bf_hi(b.z), bf_lo(b.w), bf_hi(b.w)};
            float s = 0.f;
#pragma unroll
            for (int k = 0; k < 16; ++k) s += v[k] * v[k];
            s = wave_sum(s);
            const float rs = __builtin_amdgcn_rsqf(s * (1.0f / D) + EPS);
            GAS f32x4* o = (GAS f32x4*)dst;
            o[lane * 2 + 0] = (f32x4){v[0] * rs * gv[0].x, v[1] * rs * gv[0].y, v[2] * rs * gv[0].z, v[3] * rs * gv[0].w};
            o[lane * 2 + 1] = (f32x4){v[4] * rs * gv[1].x, v[5] * rs * gv[1].y, v[6] * rs * gv[1].z, v[7] * rs * gv[1].w};
            o[128 + lane * 2 + 0] = (f32x4){v[8] * rs * gv[2].x, v[9] * rs * gv[2].y, v[10] * rs * gv[2].z, v[11] * rs * gv[2].w};
            o[128 + lane * 2 + 1] = (f32x4){v[12] * rs * gv[3].x, v[13] * rs * gv[3].y, v[14] * rs * gv[3].z, v[15] * rs * gv[3].w};
        }
    }
#undef IN
#undef SEAM
}

extern "C" void kernel_launch(void* const* d_in, const int* in_sizes, int n_in, void* d_out, int out_size, void* d_ws, size_t ws_size, hipStream_t stream) {
    static int ready = 0;
    if (ready == 0) {
        if (n_in != 20 || out_size != (int)O_END || ws_size < WS_END) { fprintf(stderr, "kernel_launch: unexpected shapes (n_in %d out %d ws %zu)\n", n_in, out_size, ws_size); ready = -1; return; }
        if (hipFuncSetAttribute((const void*)fwd_kernel, hipFuncAttributeMaxDynamicSharedMemorySize, LDS_BYTES) != hipSuccess) { fprintf(stderr, "kernel_launch: hipFuncSetAttribute failed\n"); ready = -1; return; }
        ready = 1;
    }
    if (ready < 0) return;
    (void)in_sizes;
    (void)hipMemsetAsync((char*)d_ws + WS_CTL, 0, CTL_BYTES, stream);
    Args a{};
    for (int i = 0; i < 20; ++i) a.in[i] = (const float*)d_in[i];
    a.out = (float*)d_out; a.ws = (unsigned char*)d_ws;
#if N_LAUNCH_MODE == 1
    a.ph_lo = 0; a.ph_hi = NPHASE;
    hipLaunchKernelGGL(fwd_kernel, dim3(256), dim3(512), LDS_BYTES, stream, a);
#else
    for (int p = 0; p < NPHASE; ++p) { a.ph_lo = p; a.ph_hi = p + 1; hipLaunchKernelGGL(fwd_kernel, dim3(256), dim3(512), LDS_BYTES, stream, a); }
#endif
}
```

```cpp
#include <hip/hip_runtime.h>
#include <cstdio>
#include <cstdint>

#ifndef PROBE_PH
#define PROBE_PH -1
#endif
#ifndef PROBE_MFMA2
#define PROBE_MFMA2 0
#endif
#ifndef PROBE_LOAD2
#define PROBE_LOAD2 0
#endif
#ifndef PROBE_STALL
#define PROBE_STALL 0
#endif
#ifndef PROBE_LDS2
#define PROBE_LDS2 0
#endif
#ifndef PROBE_MFMAONLY
#define PROBE_MFMAONLY 0
#endif
#ifndef PROBE_XCC
#define PROBE_XCC 0
#endif
#ifndef PROBE_DRY
#define PROBE_DRY 0
#endif
#ifndef PROBE_STORE
#define PROBE_STORE 0
#endif
#ifndef PROBE_EPI
#define PROBE_EPI 0
#endif
#ifndef SKEW_UNITS
#define SKEW_UNITS 0
#endif
#ifndef NT_WEIGHTS
#define NT_WEIGHTS 0
#endif
#ifndef PROBE_REPS
#define PROBE_REPS 0
#endif
#ifndef N_LAUNCH_MODE
#define N_LAUNCH_MODE 1
#endif

#define LAS __attribute__((address_space(3)))
#define GAS __attribute__((address_space(1)))
typedef unsigned short bf16;
typedef short bf16x8 __attribute__((ext_vector_type(8)));
typedef float f32x4 __attribute__((ext_vector_type(4)));
typedef float f32x2 __attribute__((ext_vector_type(2)));
typedef unsigned u32x4 __attribute__((ext_vector_type(4)));
typedef unsigned u32x2 __attribute__((ext_vector_type(2)));

constexpr int D = 1024, SEQ = 2048, NB = 8, DB = 128, DS = 8, DEPTH = 2, PW = 512, CW = 512, DFF = 4096, PLE = 256, INC = 2048;
constexpr int MP = NB * SEQ, MS = DB * DS, MT = MP + MS;
constexpr int NPAN = 64, PR = 272;
constexpr float EPS = 1e-6f;
constexpr int NPHASE = 15;

constexpr size_t O_YP = 0, O_YS = O_YP + (size_t)MP * D, O_NPP = O_YS + (size_t)MS * D, O_NCP = O_NPP + (size_t)DEPTH * NB * 15 * PW,
                 O_NPS = O_NCP + (size_t)DEPTH * NB * 2 * CW, O_NCS = O_NPS + (size_t)DEPTH * DB * 15 * PW, O_END = O_NCS + (size_t)DEPTH * DB * 2 * CW;

constexpr size_t MiB = 1u << 20;
constexpr size_t WS_CTL = 0, CTL_BYTES = 64 * 1024;
constexpr int NSLOT = 32;
constexpr size_t WS_SSQ0 = 1 * MiB, SSQ_BYTES = (size_t)MT * NSLOT * 4;
constexpr size_t WS_SSQ1 = WS_SSQ0 + 2 * MiB + 256 * 1024;
constexpr size_t WS_FOLD = 6 * MiB;
constexpr size_t WS_W = 10 * MiB;
constexpr size_t W_IN = 0, W_OUT = 4 * MiB, W_UP = 6 * MiB, W_DN = 14 * MiB, W_G = 22 * MiB, W_P = 24 * MiB, W_LAYER = 24 * MiB + 512 * 1024;
constexpr size_t WS_HA = WS_W + 2 * W_LAYER;
constexpr size_t WS_PB = WS_HA + 34 * MiB;
constexpr size_t WS_R = WS_PB + 17 * MiB;
constexpr size_t R_PROJ = 0, R_MIX = 68 * MiB, R_HB = 102 * MiB, R_F = 0, R_STASH = 0;
constexpr size_t WS_END = WS_R + 136 * MiB;
static_assert(WS_END <= 256 * MiB, "ws map");
static_assert((size_t)MT * D * 2 == 34 * MiB && (size_t)MT * DFF * 2 == 136 * MiB && (size_t)MT * INC * 2 == 68 * MiB, "sizes");

constexpr int SUBT = 1024;
constexpr int A_SUBS = 17, B_SUBS = 16, STAGE_BYTES = (A_SUBS + B_SUBS) * SUBT;
constexpr int NSLOTS = 4;
constexpr int MISC_OFF = NSLOTS * STAGE_BYTES;
constexpr int RSTD_OFF = MISC_OFF + 1024;
constexpr int LDS_BYTES = RSTD_OFF + 1280 + 16640;

#define VM_WAIT() asm volatile("s_waitcnt vmcnt(0)" ::: "memory")
#define LGKM_WAIT() asm volatile("s_waitcnt lgkmcnt(0)" ::: "memory")
#define LAUNDER_V(x_) asm volatile("" : "+v"(x_))
#define LAUNDER_S(x_) asm volatile("" : "+s"(x_))
__device__ __forceinline__ unsigned long long tstamp() { unsigned long long t; asm volatile("s_memtime %0\n\ts_waitcnt lgkmcnt(0)" : "=s"(t) :: "memory"); return t; }
__device__ __forceinline__ unsigned long long rstamp() { unsigned long long t; asm volatile("s_memrealtime %0\n\ts_waitcnt lgkmcnt(0)" : "=s"(t) :: "memory"); return t; }
#define BAR() do { asm volatile("" ::: "memory"); __builtin_amdgcn_s_barrier(); asm volatile("" ::: "memory"); } while (0)
__device__ __forceinline__ unsigned cvt_pk_bf16(float lo, float hi) { unsigned r; asm volatile("v_cvt_pk_bf16_f32 %0, %1, %2" : "=v"(r) : "v"(lo), "v"(hi)); return r; }
__device__ __forceinline__ float bf_lo(unsigned u) { return __builtin_bit_cast(float, u << 16); }
__device__ __forceinline__ float bf_hi(unsigned u) { return __builtin_bit_cast(float, u & 0xffff0000u); }
__device__ __forceinline__ float wave_sum(float v) {
#pragma unroll
    for (int o = 1; o < 64; o <<= 1) v += __shfl_xor(v, o);
    return v;
}

#define XB_TMO      128
#define XB_XCNT(j)  (256  + 64 * (j))
#define XB_XSUB(j)  (1280 + 64 * (j))
#define XB_XGEN(j)  (2304 + 64 * (j))
#define XB_TOP      3328
#define XB_TOPGEN   3392
#define XCD_BAR_WORDS 3456
#define XB_SPIN_CAP (1u << 18)
__device__ __forceinline__ unsigned xb_ld(unsigned* p)              { return __hip_atomic_load(p, __ATOMIC_RELAXED, __HIP_MEMORY_SCOPE_AGENT); }
__device__ __forceinline__ unsigned xb_add(unsigned* p, unsigned v) { return __hip_atomic_fetch_add(p, v, __ATOMIC_RELAXED, __HIP_MEMORY_SCOPE_AGENT); }
__device__ __forceinline__ unsigned xb_xcc_id() { return (unsigned)__builtin_amdgcn_s_getreg((3 << 11) | 20) & 0xFu; }
#define XB_SPIN(cond, bar) do { unsigned _sp = 0; while (cond) { __builtin_amdgcn_s_sleep(1); \
    if ((++_sp & 255u) == 0u) { if (xb_ld(&(bar)[XB_TMO])) break; if (_sp > XB_SPIN_CAP) { atomicAdd(&(bar)[XB_TMO], 1u); break; } } } } while (0)
struct XcdBarrier { unsigned* bar; unsigned x; volatile LAS unsigned* st; };
__device__ __forceinline__ XcdBarrier xcd_barrier_post(unsigned* bar, volatile LAS unsigned* st) {
    XcdBarrier b; b.bar = bar; b.x = xb_xcc_id(); b.st = st;
    if (threadIdx.x == 0) (void)xb_add(&bar[XB_XCNT(b.x)], 1u);
    return b;
}
__device__ __forceinline__ void xcd_barrier_complete(unsigned* bar, unsigned x, unsigned& nloc, unsigned& nx) {
    const unsigned G = gridDim.x * gridDim.y * gridDim.z;
    unsigned sum, cnt, mine, sp = 0u;
    for (;;) {
        sum = 0u; cnt = 0u; mine = 0u;
#pragma unroll
        for (unsigned j = 0; j < 16; ++j) { const unsigned c = xb_ld(&bar[XB_XCNT(j)]); sum += c; cnt += (c > 0u) ? 1u : 0u; mine = (j == x) ? c : mine; }
        if (sum == G) break;
        __builtin_amdgcn_s_sleep(1);
        if ((++sp & 255u) == 0u) { if (xb_ld(&bar[XB_TMO])) break; if (sp > XB_SPIN_CAP) { atomicAdd(&bar[XB_TMO], 1u); break; } }
    }
    nloc = mine > 0u ? mine : 1u; nx = cnt > 0u ? cnt : 1u;
}
__device__ __forceinline__ void xcd_barrier(const XcdBarrier& b) {
    asm volatile("s_waitcnt vmcnt(0)" ::: "memory");
    __syncthreads();
    if (threadIdx.x == 0) {
        unsigned* bar = b.bar;
        __builtin_amdgcn_s_waitcnt(0);
        unsigned nloc = b.st[0], nx = b.st[1];
        if (nloc == 0u) { xcd_barrier_complete(bar, b.x, nloc, nx); b.st[0] = nloc; b.st[1] = nx; }
        const unsigned old = xb_add(&bar[XB_XSUB(b.x)], 1u);
        const unsigned gen = old / nloc;
        if (old + 1u == (gen + 1u) * nloc) {
            __builtin_amdgcn_fence(__ATOMIC_RELEASE, "agent");
            asm volatile("s_waitcnt vmcnt(0)" ::: "memory");
            const unsigned og = xb_add(&bar[XB_TOP], 1u);
            const unsigned tg = og / nx;
            if (og + 1u == (tg + 1u) * nx) xb_add(&bar[XB_TOPGEN], 1u);
            else XB_SPIN(xb_ld(&bar[XB_TOPGEN]) == tg, bar);
            __builtin_amdgcn_fence(__ATOMIC_ACQUIRE, "agent");
            xb_add(&bar[XB_XGEN(b.x)], 1u);
            asm volatile("s_waitcnt vmcnt(0)" ::: "memory");
        } else {
            XB_SPIN(xb_ld(&bar[XB_XGEN(b.x)]) == gen, bar);
            __builtin_amdgcn_fence(__ATOMIC_ACQUIRE, "agent");
            asm volatile("s_waitcnt vmcnt(0)" ::: "memory");
        }
    }
    __syncthreads();
}

struct Args { const float* in[20]; float* out; unsigned char* ws; int ph_lo, ph_hi; };


__device__ __forceinline__ void glds16s(unsigned voff, unsigned long long sbase, unsigned slot, unsigned ldsoff) {
    asm volatile("s_add_u32 m0, %2, %3\n\ts_nop 0\n\tglobal_load_lds_dwordx4 %0, %1" :: "v"(voff), "s"(sbase), "s"(slot), "s"(ldsoff) : "memory", "m0", "scc");
}
__device__ __forceinline__ void glds16s_nt(unsigned voff, unsigned long long sbase, unsigned slot, unsigned ldsoff) {
#if NT_WEIGHTS
    asm volatile("s_add_u32 m0, %2, %3\n\ts_nop 0\n\tglobal_load_lds_dwordx4 %0, %1 nt" :: "v"(voff), "s"(sbase), "s"(slot), "s"(ldsoff) : "memory", "m0", "scc");
#else
    glds16s(voff, sbase, slot, ldsoff);
#endif
}
constexpr unsigned ABLK = PR * 128, BBLK = 256 * 128;
__device__ __forceinline__ unsigned ablk(int pm, int lr, int col, int KT) { return (unsigned)(((pm * KT + (col >> 6)) * PR + lr) * 64 + (col & 63)); }
struct Seg { unsigned long long a, b; int nsub; };

#define ISSUE_SUB(slotoff_) do { const unsigned so_ = (unsigned)(unsigned long long)(lds + (slotoff_)); \
    glds16s(voA0, ca, so_, lA0); glds16s(voA1, ca, so_, lA0 + 8 * SUBT); glds16s_nt(voB0, cbp, so_, lB0); glds16s_nt(voB1, cbp, so_, lB0 + 8 * SUBT); \
    if (wave == 0) glds16s(voX, ca, so_, 16 * SUBT); \
    ca += cpar ? (ABLK - 64) : 64; cbp += cpar ? (BBLK - 64) : 64; cpar ^= 1; \
    if (--cleft == 0) { ck = (ck + 1 < S.nseg()) ? ck + 1 : ck; cseg = S.seg(ck); ca = cseg.a; cbp = cseg.b; cleft = cseg.nsub; cpar = 0; } } while (0)

#define LDA(slotoff_, m_) (*(const LAS bf16x8*)(lds + (slotoff_) + aoff + (m_) * SUBT + rdoff))
#define LDAX(slotoff_)    (*(const LAS bf16x8*)(lds + (slotoff_) + 16 * SUBT + rdoff))
#define LDB(slotoff_, n_) (*(const LAS bf16x8*)(lds + (slotoff_) + boff + (n_) * SUBT + rdoff))
#define MFMA(a_, b_, c_) c_ = __builtin_amdgcn_mfma_f32_16x16x32_bf16(b_, a_, c_, 0, 0, 0)

struct Acc { f32x4 m[8][4]; f32x4 x[2]; };
__device__ __forceinline__ void zero_acc(Acc& a) {
#pragma unroll
    for (int m = 0; m < 8; ++m)
#pragma unroll
        for (int n = 0; n < 4; ++n) a.m[m][n] = (f32x4){0.f, 0.f, 0.f, 0.f};
    a.x[0] = (f32x4){0.f, 0.f, 0.f, 0.f}; a.x[1] = (f32x4){0.f, 0.f, 0.f, 0.f};
}

#define SB() __builtin_amdgcn_sched_barrier(0)
#define VMCNT_I(n_) asm volatile("s_waitcnt vmcnt(%0)" :: "i"(n_) : "memory")
template <int NST> __device__ __forceinline__ void ring_wait(int& epi_left, int wave) {
    if (epi_left > 0) { --epi_left; if (wave == 0) VMCNT_I(10 + NST); else VMCNT_I(8 + NST); }
    else { if (wave == 0) VMCNT_I(10); else VMCNT_I(8); }
}

template <int DRY = 0, class SRC, class POST>
__device__ __forceinline__ void gemm_stream(LAS unsigned char* lds, const SRC& S, POST& P, const int ntot, const int wave_in, const int lane_in, unsigned long long& stall) {
    int lane = lane_in; LAUNDER_V(lane); int wave = wave_in; LAUNDER_S(wave);
    const int fr = lane & 15, fq = lane >> 4, wr = wave >> 2, wc = wave & 3;
    const unsigned rdoff = (unsigned)((fr * 64 + fq * 16) ^ ((fr >> 3) << 5));
    const int b16 = lane * 16, swz = b16 ^ (((b16 >> 9) & 1) << 5), rr = swz >> 6, cb = swz & 63, pr = 16 * (rr >> 2) + (rr & 3);
    const unsigned aoff = (unsigned)(8 * wr) * SUBT, boff = (unsigned)(A_SUBS + 4 * wc) * SUBT;
    const bool hi = (wr != 0);
    int epi_left = 0;
    Acc acc; zero_acc(acc);
    bf16x8 Bf[4], F[9];
    const int NS = 2 * ntot;
    int ck = 0; Seg cseg = S.seg(0); unsigned long long ca = cseg.a, cbp = cseg.b; int cleft = cseg.nsub; int cpar = 0;
    const unsigned voA0 = (unsigned)(16 * wave + rr) * 128u + (unsigned)cb, voA1 = voA0 + 128u * 128u, voX = (unsigned)(256 + rr) * 128u + (unsigned)cb;
    const unsigned voB0 = (unsigned)(64 * (wave >> 2) + 4 * (wave & 3) + pr) * 128u + (unsigned)cb, voB1 = voB0 + 128u * 128u;
    const unsigned lA0 = (unsigned)wave * SUBT, lB0 = (unsigned)(A_SUBS + wave) * SUBT;
    if (SKEW_UNITS > 0 && DRY == 0) { const int dly = S.skew(); for (int i = 0; i < dly; ++i) __builtin_amdgcn_s_sleep(SKEW_UNITS); }
    ISSUE_SUB(0); ISSUE_SUB(STAGE_BYTES); ISSUE_SUB(2 * STAGE_BYTES);
    ring_wait<0>(epi_left, wave);
    BAR();
    if (hi) BAR();
#if PROBE_STALL == 9 || PROBE_STALL == 10
    const unsigned long long tl0_ = (PROBE_STALL == 9) ? rstamp() : tstamp();
#elif PROBE_STALL >= 6 && PROBE_STALL <= 8
    const unsigned long long tl0_ = tstamp();
#endif
    bool pend = false;
#pragma unroll 1
    for (int s = 0; s < NS; ++s) {
        const unsigned cs = (unsigned)(s & 3) * STAGE_BYTES, rs = (unsigned)((s + 3) & 3) * STAGE_BYTES;
        SB();
        ISSUE_SUB(rs);
        if (DRY == 0) { if (pend) { P.run(acc, wr, wc, fr, fq); pend = false; epi_left = 3; } }
        if (DRY != 1) {
#pragma unroll
        for (int n = 0; n < 4; ++n) Bf[n] = LDB(cs, n);
#pragma unroll
        for (int m = 0; m < 8; ++m) F[m] = LDA(cs, m);
        F[8] = LDAX(cs);
        }
        if (hi) ring_wait<POST::NST>(epi_left, wave);
        LGKM_WAIT();
        SB(); BAR(); SB();
        if (DRY != 1) {
#pragma unroll
        for (int m = 0; m < 8; ++m)
#pragma unroll
            for (int n = 0; n < 4; ++n) MFMA(F[m], Bf[n], acc.m[m][n]);
        { const bf16x8 bx0 = hi ? Bf[2] : Bf[0], bx1 = hi ? Bf[3] : Bf[1]; MFMA(F[8], bx0, acc.x[0]); MFMA(F[8], bx1, acc.x[1]); }
        }
        if (DRY == 0) { if ((s & 1) && P.due()) { if (hi) { P.run(acc, wr, wc, fr, fq); epi_left = 2; } else pend = true; } }
        if (!hi) ring_wait<POST::NST>(epi_left, wave);
        SB(); BAR(); SB();
    }
    if (DRY == 0) { if (pend) P.run(acc, wr, wc, fr, fq); }
    if (!hi) BAR();
    LGKM_WAIT(); VM_WAIT(); BAR();
}

__device__ __forceinline__ void panel_rstd(LAS unsigned char* lds, const float* ssq, int pm, int tid) {
    LAS float* rt = (LAS float*)(lds + RSTD_OFF);
    if (tid < PR) {
        const GAS f32x4* p = (const GAS f32x4*)(ssq + (size_t)(pm * PR + tid) * NSLOT);
        float s = 0.f;
#pragma unroll
        for (int i = 0; i < NSLOT / 4; ++i) { const f32x4 q = p[i]; s += (q.x + q.y) + (q.z + q.w); }
        rt[tid] = __builtin_amdgcn_rsqf(s * (1.0f / D) + EPS);
    }
    __syncthreads();
}
#define RSTD(r_) (((const LAS float*)(lds + RSTD_OFF))[r_])
__device__ __forceinline__ void store16(bf16* p, const float (&v)[16]) {
    u32x4 a, b;
    a.x = cvt_pk_bf16(v[0], v[1]); a.y = cvt_pk_bf16(v[2], v[3]); a.z = cvt_pk_bf16(v[4], v[5]); a.w = cvt_pk_bf16(v[6], v[7]);
    b.x = cvt_pk_bf16(v[8], v[9]); b.y = cvt_pk_bf16(v[10], v[11]); b.z = cvt_pk_bf16(v[12], v[13]); b.w = cvt_pk_bf16(v[14], v[15]);
    *(GAS u32x4*)p = a; *(GAS u32x4*)(p + 8) = b;
}
__device__ __forceinline__ void store8(bf16* p, const float (&v)[8]) {
    u32x4 a;
    a.x = cvt_pk_bf16(v[0], v[1]); a.y = cvt_pk_bf16(v[2], v[3]); a.z = cvt_pk_bf16(v[4], v[5]); a.w = cvt_pk_bf16(v[6], v[7]);
    *(GAS u32x4*)p = a;
}
__device__ __forceinline__ void load16(const bf16* p, float (&v)[16]) {
    const u32x4 a = *(const GAS u32x4*)p, b = *(const GAS u32x4*)(p + 8);
    v[0] = bf_lo(a.x); v[1] = bf_hi(a.x); v[2] = bf_lo(a.y); v[3] = bf_hi(a.y); v[4] = bf_lo(a.z); v[5] = bf_hi(a.z); v[6] = bf_lo(a.w); v[7] = bf_hi(a.w);
    v[8] = bf_lo(b.x); v[9] = bf_hi(b.x); v[10] = bf_lo(b.y); v[11] = bf_hi(b.y); v[12] = bf_lo(b.z); v[13] = bf_hi(b.z); v[14] = bf_lo(b.w); v[15] = bf_hi(b.w);
}
__device__ __forceinline__ void load8(const bf16* p, float (&v)[8]) {
    const u32x4 a = *(const GAS u32x4*)p;
    v[0] = bf_lo(a.x); v[1] = bf_hi(a.x); v[2] = bf_lo(a.y); v[3] = bf_hi(a.y); v[4] = bf_lo(a.z); v[5] = bf_hi(a.z); v[6] = bf_lo(a.w); v[7] = bf_hi(a.w);
}

struct SrcPlain {
    const unsigned char* A; const unsigned char* B; int nt, pn0, nu; int sk;
    __device__ __forceinline__ int skew() const { return sk; }
    __device__ __forceinline__ int nseg() const { return nu; }
    __device__ __forceinline__ Seg seg(int u) const { Seg r; r.a = (unsigned long long)A; r.b = (unsigned long long)(B + (size_t)(pn0 + u) * nt * BBLK); r.nsub = 2 * nt; return r; }
};
struct SrcPle {
    const unsigned char* Ap; const unsigned char* Bp; const unsigned char* Ah; const unsigned char* Bg; int sk;
    __device__ __forceinline__ int skew() const { return sk; }
    __device__ __forceinline__ int nseg() const { return 2; }
    __device__ __forceinline__ Seg seg(int k) const { Seg r;
        if (k == 0) { r.a = (unsigned long long)Ap; r.b = (unsigned long long)Bp; r.nsub = 8; }
        else { r.a = (unsigned long long)Ah; r.b = (unsigned long long)Bg; r.nsub = 32; }
        return r; }
};

template <int ACT>
struct PostScale {
    static constexpr int NST = 17;
    LAS unsigned char* lds; bf16* out; int ldo, pm, pn0, nt, tc, u; int mode = 0;
    static __device__ __forceinline__ float act(float x) { if (ACT == 1) { x = fmaxf(x, 0.f); x = x * x; } return x; }
    __device__ __forceinline__ bool due() { if (++tc < nt) return false; tc = 0; return true; }
    __device__ __forceinline__ void run(Acc& acc, int wr, int wc, int fr, int fq) {
        int lr0 = 128 * wr + fr; LAUNDER_V(lr0);
        const int KT = ldo >> 6;
        GAS unsigned char* ob = (GAS unsigned char*)out + 2u * (unsigned)(((pm * KT + (pn0 + u) * 4 + wc) * PR + lr0) * 64 + 16 * fq);
        float rsv[9];
#pragma unroll
        for (int m = 0; m < 8; ++m) rsv[m] = RSTD(lr0 + 16 * m);
        rsv[8] = RSTD(256 + (lr0 & 15));
#pragma unroll
        for (int m = 0; m < 8; ++m) { float v[16];
#pragma unroll
            for (int k = 0; k < 16; ++k) v[k] = act(acc.m[m][k >> 2][k & 3] * rsv[m]);
            store16((bf16*)(ob + (unsigned)(16 * m) * 128u), v); }
        { const int lrx = 256 + (lr0 & 15);
            float v[8];
#pragma unroll
            for (int k = 0; k < 8; ++k) v[k] = act(acc.x[k >> 2][k & 3] * rsv[8]);
            store8((bf16*)((GAS unsigned char*)out + 2u * (unsigned)(((pm * KT + (pn0 + u) * 4 + wc) * PR + lrx) * 64 + 16 * fq + 8 * wr)), v); }
        zero_acc(acc); ++u;
    }
};
struct PostRes {
    static constexpr int NST = 26;
    const bf16* hin; bf16* hout; float* ssq_out; int pm, pn, nt, tc;
    __device__ __forceinline__ bool due() { if (++tc < nt) return false; tc = 0; return true; }
    __device__ __forceinline__ void run(Acc& acc, int wr, int wc, int fr, int fq) {
        int row0 = pm * PR + 128 * wr + fr; LAUNDER_V(row0);
        const int lr0 = row0 - pm * PR;
        const unsigned eb = 2u * (unsigned)(((pm * 16 + pn * 4 + wc) * PR + lr0) * 64 + 16 * fq);
        const GAS unsigned char* ib = (const GAS unsigned char*)hin + eb; GAS unsigned char* ob = (GAS unsigned char*)hout + eb;
        float* sq = ssq_out + (unsigned)row0 * NSLOT + 8 * pn + 2 * wc;
        const int rowx = pm * PR + 256 + (lr0 - 128 * wr);
        const unsigned eox = 2u * (unsigned)(((pm * 16 + pn * 4 + wc) * PR + 256 + (lr0 - 128 * wr)) * 64 + 16 * fq + 8 * wr);
        u32x4 hv[8][2], hx;
#pragma unroll
        for (int m = 0; m < 6; ++m) { hv[m][0] = *(const GAS u32x4*)(ib + (unsigned)(16 * m) * 128u); hv[m][1] = *(const GAS u32x4*)(ib + (unsigned)(16 * m) * 128u + 16); }
#pragma unroll
        for (int m = 0; m < 8; ++m) { float v[16]; const u32x4 a = hv[m][0], b = hv[m][1];
            if (m == 1) {
#pragma unroll
                for (int m2 = 6; m2 < 8; ++m2) { hv[m2][0] = *(const GAS u32x4*)(ib + (unsigned)(16 * m2) * 128u); hv[m2][1] = *(const GAS u32x4*)(ib + (unsigned)(16 * m2) * 128u + 16); }
                hx = *(const GAS u32x4*)((const GAS unsigned char*)hin + eox);
                __builtin_amdgcn_sched_barrier(0); }
            v[0] = bf_lo(a.x); v[1] = bf_hi(a.x); v[2] = bf_lo(a.y); v[3] = bf_hi(a.y); v[4] = bf_lo(a.z); v[5] = bf_hi(a.z); v[6] = bf_lo(a.w); v[7] = bf_hi(a.w);
            v[8] = bf_lo(b.x); v[9] = bf_hi(b.x); v[10] = bf_lo(b.y); v[11] = bf_hi(b.y); v[12] = bf_lo(b.z); v[13] = bf_hi(b.z); v[14] = bf_lo(b.w); v[15] = bf_hi(b.w);
            float ss = 0.f;
#pragma unroll
            for (int k = 0; k < 16; ++k) { v[k] += acc.m[m][k >> 2][k & 3]; ss += v[k] * v[k]; }
            store16((bf16*)(ob + (unsigned)(16 * m) * 128u), v);
            ss += __shfl_xor(ss, 16); ss += __shfl_xor(ss, 32);
            if (fq == 0) *(GAS f32x2*)(sq + (unsigned)(16 * m) * NSLOT) = (f32x2){ss, 0.f}; }
        { float v[8]; v[0] = bf_lo(hx.x); v[1] = bf_hi(hx.x); v[2] = bf_lo(hx.y); v[3] = bf_hi(hx.y); v[4] = bf_lo(hx.z); v[5] = bf_hi(hx.z); v[6] = bf_lo(hx.w); v[7] = bf_hi(hx.w);
            float ss = 0.f;
#pragma unroll
            for (int k = 0; k < 8; ++k) { v[k] += acc.x[k >> 2][k & 3]; ss += v[k] * v[k]; }
            store8((bf16*)((GAS unsigned char*)hout + eox), v);
            ss += __shfl_xor(ss, 16); ss += __shfl_xor(ss, 32);
            if (fq == 0) ssq_out[(unsigned)rowx * NSLOT + 8 * pn + 2 * wc + wr] = ss; }
        zero_acc(acc);
    }
};
struct PostPle {
    static constexpr int NST = 17;
    LAS unsigned char* lds; const bf16* hin; bf16* hout; float* ssq_out; float* stash; int pm, pn;
    int g = -1, gdue = 0;
    __device__ __forceinline__ bool due() { ++g; if (g != 3 && g != 19) return false; gdue = g; return true; }
    __device__ __forceinline__ void run(Acc& acc, int wr, int wc, int fr, int fq) {
        const int g = gdue;
        int tid = (wr * 4 + wc) * 64 + fq * 16 + fr; LAUNDER_V(tid);
        GAS u32x4* st = (GAS u32x4*)stash + tid;
        if (g == 3) {
#pragma unroll
            for (int m = 0; m < 8; ++m)
#pragma unroll
                for (int hf = 0; hf < 2; ++hf) { u32x4 w; w.x = cvt_pk_bf16(acc.m[m][2 * hf][0], acc.m[m][2 * hf][1]); w.y = cvt_pk_bf16(acc.m[m][2 * hf][2], acc.m[m][2 * hf][3]);
                    w.z = cvt_pk_bf16(acc.m[m][2 * hf + 1][0], acc.m[m][2 * hf + 1][1]); w.w = cvt_pk_bf16(acc.m[m][2 * hf + 1][2], acc.m[m][2 * hf + 1][3]);
                    st[(2 * m + hf) * 512] = w; }
            { u32x4 w; w.x = cvt_pk_bf16(acc.x[0][0], acc.x[0][1]); w.y = cvt_pk_bf16(acc.x[0][2], acc.x[0][3]); w.z = cvt_pk_bf16(acc.x[1][0], acc.x[1][1]); w.w = cvt_pk_bf16(acc.x[1][2], acc.x[1][3]);
              st[16 * 512] = w; }
            zero_acc(acc);
        } else {
            int lr0 = 128 * wr + fr; LAUNDER_V(lr0);
            const int row0 = pm * PR + lr0;
            const unsigned eb = 2u * (unsigned)(((pm * 16 + pn * 4 + wc) * PR + lr0) * 64 + 16 * fq);
            const GAS unsigned char* ib = (const GAS unsigned char*)hin + eb; GAS unsigned char* ob = (GAS unsigned char*)hout + eb;
            float* sq = ssq_out + (unsigned)row0 * NSLOT + 8 * pn + 2 * wc;
#pragma unroll
            for (int m = 0; m < 8; ++m) { const int g16 = 16 * m; const float rs = RSTD(lr0 + g16);
                const unsigned o = (unsigned)g16 * 128u;
                float v[16], pp[16];
#pragma unroll
                for (int hf = 0; hf < 2; ++hf) { const u32x4 a = *(const GAS u32x4*)(ib + o + 16 * hf), p = st[(2 * m + hf) * 512];
                    v[8 * hf + 0] = bf_lo(a.x); v[8 * hf + 1] = bf_hi(a.x); v[8 * hf + 2] = bf_lo(a.y); v[8 * hf + 3] = bf_hi(a.y); v[8 * hf + 4] = bf_lo(a.z); v[8 * hf + 5] = bf_hi(a.z); v[8 * hf + 6] = bf_lo(a.w); v[8 * hf + 7] = bf_hi(a.w);
                    pp[8 * hf + 0] = bf_lo(p.x); pp[8 * hf + 1] = bf_hi(p.x); pp[8 * hf + 2] = bf_lo(p.y); pp[8 * hf + 3] = bf_hi(p.y); pp[8 * hf + 4] = bf_lo(p.z); pp[8 * hf + 5] = bf_hi(p.z); pp[8 * hf + 6] = bf_lo(p.w); pp[8 * hf + 7] = bf_hi(p.w); }
                float ss = 0.f;
#pragma unroll
                for (int k = 0; k < 16; ++k) { const float gt = 1.0f / (1.0f + __expf(-acc.m[m][k >> 2][k & 3] * rs)); v[k] += gt * pp[k]; ss += v[k] * v[k]; }
                store16((bf16*)(ob + o), v);
                ss += __shfl_xor(ss, 16); ss += __shfl_xor(ss, 32);
                if (fq == 0) *(GAS f32x2*)(sq + (unsigned)g16 * NSLOT) = (f32x2){ss, 0.f}; }
            { const int lrx = 256 + fr; const int rowx = pm * PR + lrx; const float rs = RSTD(lrx);
                const unsigned eo = 2u * (unsigned)(((pm * 16 + pn * 4 + wc) * PR + lrx) * 64 + 16 * fq + 8 * wr);
                float v[8], pp[8]; load8((const bf16*)((const GAS unsigned char*)hin + eo), v);
                { const u32x4 p = st[16 * 512]; pp[0] = bf_lo(p.x); pp[1] = bf_hi(p.x); pp[2] = bf_lo(p.y); pp[3] = bf_hi(p.y); pp[4] = bf_lo(p.z); pp[5] = bf_hi(p.z); pp[6] = bf_lo(p.w); pp[7] = bf_hi(p.w); }
                float ss = 0.f;
#pragma unroll
                for (int k = 0; k < 8; ++k) { const float gt = 1.0f / (1.0f + __expf(-acc.x[k >> 2][k & 3] * rs)); v[k] += gt * pp[k]; ss += v[k] * v[k]; }
                store8((bf16*)((GAS unsigned char*)hout + eo), v);
                ss += __shfl_xor(ss, 16); ss += __shfl_xor(ss, 32);
                if (fq == 0) ssq_out[(unsigned)rowx * NSLOT + 8 * pn + 2 * wc + wr] = ss; }
        }
    }
};

__device__ __forceinline__ const float* x_row(const float* xp, const float* xs, int R) { const int pm = R / PR, i = R - pm * PR;
    return i < 256 ? xp + (size_t)(256 * pm + i) * D : xs + (size_t)(16 * pm + i - 256) * D; }

__device__ __forceinline__ void transpose64(const float* W, int ldw, const float* gain, bf16* WT, int K, int k0, int n0, LAS float* scr, int lane) {
    const int kr = lane >> 4, nq = lane & 15;
    const GAS float* src = (const GAS float*)W + (size_t)(k0 + kr) * ldw + n0 + 4 * nq;
    f32x4 v[16];
#pragma unroll
    for (int i = 0; i < 16; ++i) v[i] = *(const GAS f32x4*)(src + (size_t)(4 * i) * ldw);
    if (gain) {
#pragma unroll
        for (int i = 0; i < 16; ++i) v[i] = v[i] * gain[k0 + 4 * i + kr];
    }
#pragma unroll
    for (int i = 0; i < 16; ++i) { LAS float* d = scr + (4 * i + kr) * 65 + 4 * nq; d[0] = v[i].x; d[1] = v[i].y; d[2] = v[i].z; d[3] = v[i].w; }
    LGKM_WAIT(); asm volatile("" ::: "memory");
    const int c = lane & 7, nr = lane >> 3;
#pragma unroll
    for (int j = 0; j < 8; ++j) { const int n = nr + 8 * j; const LAS float* s = scr + (8 * c) * 65 + n;
        u32x4 o; o.x = cvt_pk_bf16(s[0 * 65], s[1 * 65]); o.y = cvt_pk_bf16(s[2 * 65], s[3 * 65]); o.z = cvt_pk_bf16(s[4 * 65], s[5 * 65]); o.w = cvt_pk_bf16(s[6 * 65], s[7 * 65]);
        *(GAS u32x4*)(WT + ((size_t)(((n0 + n) >> 8) * (K >> 6) + (k0 >> 6)) * 256 + ((n0 + n) & 255)) * 64 + 8 * c) = o; }
    LGKM_WAIT(); asm volatile("" ::: "memory");
}

struct MixCtx { const bf16* proj; bf16* mix; const float* state_pool; const float* state_conv; const float* conv_w; const float* conv_b;
                float* npp; float* ncp; float* nps; float* ncs; int layer; };
__device__ __forceinline__ f32x4 ld_bf4(const GAS unsigned char* p) { const u32x2 u = *(const GAS u32x2*)p; return (f32x4){bf_lo(u.x), bf_hi(u.x), bf_lo(u.y), bf_hi(u.y)}; }
__device__ __forceinline__ void st_bf4(GAS unsigned char* p, f32x4 v) { *(GAS u32x2*)p = (u32x2){cvt_pk_bf16(v.x, v.y), cvt_pk_bf16(v.z, v.w)}; }
__device__ __forceinline__ unsigned prow_of(int b, int t) { return (unsigned)((8 * b + (t >> 8)) * PR + (t & 255)); }
__device__ __forceinline__ unsigned pbyte(int b, int t, int col, int KT) { return 2u * ablk(8 * b + (t >> 8), t & 255, col, KT); }

__device__ __forceinline__ void mix_prompt(const MixCtx& M, int pm, int q, int tid) {
    const int b = pm >> 3, layer = M.layer;
    const int role = tid >> 8, rg = (tid >> 7) & 1, c4 = (tid & 127) * 4;
    const int t0 = (pm & 7) * 256 + 64 * q + 32 * rg;
    const GAS unsigned char* pb_ = (const GAS unsigned char*)M.proj; GAS unsigned char* mb_ = (GAS unsigned char*)M.mix;
    if (role == 0) {
        const int W = 2 << (c4 >> 7);
        f32x4 S = {0.f, 0.f, 0.f, 0.f};
#pragma unroll
        for (int j = 1; j < 16; ++j) { const int p = t0 - j; const f32x4 hv_ = ld_bf4(pb_ + pbyte(b, p >= 0 ? p : 0, c4, 32)); if (p >= 0 && j < W) S += hv_; }
        {
            u32x2 ar[32], orr[32];
#pragma unroll
            for (int i = 0; i < 32; ++i) { const int p = t0 + i, po = p - W + 1;
                ar[i] = *(const GAS u32x2*)(pb_ + pbyte(b, p, c4, 32)); orr[i] = *(const GAS u32x2*)(pb_ + pbyte(b, po >= 0 ? po : 0, c4, 32)); }
#pragma unroll
            for (int i = 0; i < 32; ++i) { const int p = t0 + i;
                const f32x4 a = {bf_lo(ar[i].x), bf_hi(ar[i].x), bf_lo(ar[i].y), bf_hi(ar[i].y)}, old = {bf_lo(orr[i].x), bf_hi(orr[i].x), bf_lo(orr[i].y), bf_hi(orr[i].y)};
                S += a;
                const int cnt = (p + 1 < W) ? p + 1 : W;
                st_bf4(mb_ + pbyte(b, p, c4, 16), S * (1.0f / (float)cnt) - a);
                if (p - W + 1 >= 0) S -= old; }
        }
    } else {
        const unsigned co = 2u * (unsigned)c4;
        const f32x4 w0 = *(const GAS f32x4*)(M.conv_w + (size_t)(layer * 3 + 0) * CW + c4), w1 = *(const GAS f32x4*)(M.conv_w + (size_t)(layer * 3 + 1) * CW + c4),
                    w2 = *(const GAS f32x4*)(M.conv_w + (size_t)(layer * 3 + 2) * CW + c4), bias = *(const GAS f32x4*)(M.conv_b + (size_t)layer * CW + c4);
        f32x4 cm2 = {0.f, 0.f, 0.f, 0.f}, cm1 = {0.f, 0.f, 0.f, 0.f};
        if (t0 >= 2) { cm2 = ld_bf4(pb_ + pbyte(b, t0 - 2, 1024 + c4, 32)) * ld_bf4(pb_ + pbyte(b, t0 - 2, 1536 + c4, 32));
                       cm1 = ld_bf4(pb_ + pbyte(b, t0 - 1, 1024 + c4, 32)) * ld_bf4(pb_ + pbyte(b, t0 - 1, 1536 + c4, 32)); }
        {
            u32x2 bgr[32], cgr[32], vr[32];
#pragma unroll
            for (int i = 0; i < 32; ++i) { const int p = t0 + i; bgr[i] = *(const GAS u32x2*)(pb_ + pbyte(b, p, 512 + c4, 32)); cgr[i] = *(const GAS u32x2*)(pb_ + pbyte(b, p, 1024 + c4, 32)); vr[i] = *(const GAS u32x2*)(pb_ + pbyte(b, p, 1536 + c4, 32)); }
#pragma unroll
            for (int i = 0; i < 32; ++i) {
                const f32x4 bg = {bf_lo(bgr[i].x), bf_hi(bgr[i].x), bf_lo(bgr[i].y), bf_hi(bgr[i].y)};
                const f32x4 cc = (f32x4){bf_lo(cgr[i].x), bf_hi(cgr[i].x), bf_lo(cgr[i].y), bf_hi(cgr[i].y)} * (f32x4){bf_lo(vr[i].x), bf_hi(vr[i].x), bf_lo(vr[i].y), bf_hi(vr[i].y)};
                const f32x4 z = bias + w0 * cm2 + w1 * cm1 + w2 * cc;
                st_bf4(mb_ + pbyte(b, t0 + i, 512 + c4, 16), bg * z);
                cm2 = cm1; cm1 = cc; }
        }
    }
    if ((pm & 7) == 7 && q == 3) {
        if (tid < 128) {
#pragma unroll 1
            for (int i = 0; i < 15; ++i) *(GAS f32x4*)(M.npp + ((size_t)(layer * NB + b) * 15 + i) * PW + c4) = ld_bf4(pb_ + pbyte(b, SEQ - 15 + i, c4, 32));
        } else if (tid >= 256 && tid < 384) {
#pragma unroll 1
            for (int i = 0; i < 2; ++i)
                *(GAS f32x4*)(M.ncp + ((size_t)(layer * NB + b) * 2 + i) * CW + c4) = ld_bf4(pb_ + pbyte(b, SEQ - 2 + i, 1024 + c4, 32)) * ld_bf4(pb_ + pbyte(b, SEQ - 2 + i, 1536 + c4, 32));
        }
    }
}
__device__ __forceinline__ void mix_sample(const MixCtx& M, int pm, int q, int tid) {
    const int sb = 2 * pm + q, layer = M.layer, c4 = (tid & 127) * 4, L0 = 256 + 8 * q;
    const GAS unsigned char* pb_ = (const GAS unsigned char*)M.proj; GAS unsigned char* mb_ = (GAS unsigned char*)M.mix;
    if (tid < 128) {
        const int W = 2 << (c4 >> 7);
        const float* sp = M.state_pool + (size_t)(layer * DB + sb) * 15 * PW + c4;
        float* nps = M.nps + (size_t)(layer * DB + sb) * 15 * PW + c4;
        f32x4 S = {0.f, 0.f, 0.f, 0.f};
#pragma unroll 1
        for (int j = 1; j < W; ++j) S += *(const GAS f32x4*)(sp + (size_t)(15 - j) * PW);
#pragma unroll 1
        for (int r = 0; r < 8; ++r) {
            const f32x4 a = ld_bf4(pb_ + 2u * ablk(pm, L0 + r, c4, 32));
            const int po = r - W + 1;
            f32x4 old; if (po >= 0) old = ld_bf4(pb_ + 2u * ablk(pm, L0 + po, c4, 32)); else old = *(const GAS f32x4*)(sp + (size_t)(15 + po) * PW);
            S += a;
            st_bf4(mb_ + 2u * ablk(pm, L0 + r, c4, 16), S * (1.0f / (float)W) - a);
            *(GAS f32x4*)(nps + (size_t)(7 + r) * PW) = a;
            S -= old; }
#pragma unroll 1
        for (int i = 0; i < 7; ++i) *(GAS f32x4*)(nps + (size_t)i * PW) = *(const GAS f32x4*)(sp + (size_t)(8 + i) * PW);
    } else if (tid >= 256 && tid < 384) {
        const float* sc = M.state_conv + (size_t)(layer * DB + sb) * 2 * CW + c4;
        const f32x4 w0 = *(const GAS f32x4*)(M.conv_w + (size_t)(layer * 3 + 0) * CW + c4), w1 = *(const GAS f32x4*)(M.conv_w + (size_t)(layer * 3 + 1) * CW + c4),
                    w2 = *(const GAS f32x4*)(M.conv_w + (size_t)(layer * 3 + 2) * CW + c4), bias = *(const GAS f32x4*)(M.conv_b + (size_t)layer * CW + c4);
        f32x4 cm2 = *(const GAS f32x4*)sc, cm1 = *(const GAS f32x4*)(sc + CW);
#pragma unroll 1
        for (int r = 0; r < 8; ++r) {
            const f32x4 bg = ld_bf4(pb_ + 2u * ablk(pm, L0 + r, 512 + c4, 32)), cc = ld_bf4(pb_ + 2u * ablk(pm, L0 + r, 1024 + c4, 32)) * ld_bf4(pb_ + 2u * ablk(pm, L0 + r, 1536 + c4, 32));
            const f32x4 z = bias + w0 * cm2 + w1 * cm1 + w2 * cc;
            st_bf4(mb_ + 2u * ablk(pm, L0 + r, 512 + c4, 16), bg * z);
            if (r >= 6) *(GAS f32x4*)(M.ncs + ((size_t)(layer * DB + sb) * 2 + (r - 6)) * CW + c4) = cc;
            cm2 = cm1; cm1 = cc; }
    }
}

__global__ void __launch_bounds__(512) fwd_kernel(Args args) {
    extern __shared__ __attribute__((aligned(16))) unsigned char lds_raw[];
    LAS unsigned char* lds = (LAS unsigned char*)lds_raw;
    const int tid = threadIdx.x, lane = tid & 63, wave = __builtin_amdgcn_readfirstlane(tid >> 6);
    const int G = gridDim.x, bx = blockIdx.x, vcu = (G % 8 == 0) ? (bx % 8) * (G / 8) + bx / 8 : bx;
    const int pm_ = vcu >> 2, q_ = vcu & 3;
    unsigned char* ws = args.ws;
    const int lo = args.ph_lo, hi = args.ph_hi;

    volatile LAS unsigned* MISC = (volatile LAS unsigned*)(lds + MISC_OFF);
    if (tid < 64) MISC[tid] = 0u;
    __syncthreads();
    XcdBarrier bar; bar.bar = (unsigned*)(ws + WS_CTL); bar.x = 0; bar.st = MISC;
    if (hi - lo > 1) bar = xcd_barrier_post((unsigned*)(ws + WS_CTL), MISC);
#ifndef PH_EN
#define PH_EN 0x7fff
#endif
#define LY_EN(i) ((PH_EN >> (2 + (i))) & 1)
#define IN(k) (lo <= (k) && (k) < hi)
#define SEAM(k) do { if (IN(k) && IN((k) + 1)) xcd_barrier(bar); } while (0)

    const float* x_prompt = args.in[0]; const float* x_sample = args.in[1]; const float* state_pool = args.in[2]; const float* state_conv = args.in[3];
    const float* p_prompt = args.in[4]; const float* p_sample = args.in[5]; const float* norm_mix = args.in[6]; const float* w_in = args.in[7];
    const float* pool_w = args.in[8]; const float* pool_scale = args.in[9]; const float* conv_w = args.in[10]; const float* conv_b = args.in[11];
    const float* w_out = args.in[12]; const float* norm_mlp = args.in[13]; const float* w_up = args.in[14]; const float* w_down = args.in[15];
    const float* norm_ple = args.in[16]; const float* w_ple_gate = args.in[17]; const float* w_ple_proj = args.in[18]; const float* norm_f = args.in[19];
    float* out = args.out;
    float* ssq0 = (float*)(ws + WS_SSQ0); float* ssq1 = (float*)(ws + WS_SSQ1);
    float* fold = (float*)(ws + WS_FOLD);
    bf16* hA = (bf16*)(ws + WS_HA); bf16* hB = (bf16*)(ws + WS_R + R_HB);
    bf16* pb = (bf16*)(ws + WS_PB);
    bf16* proj = (bf16*)(ws + WS_R + R_PROJ); bf16* mixA = (bf16*)(ws + WS_R + R_MIX); bf16* fbuf = (bf16*)(ws + WS_R + R_F);
    float* stash = (float*)(ws + WS_R + R_STASH) + (size_t)bx * (PR * 256);
    const int gw = vcu * 8 + wave, NGW = G * 8;
    unsigned long long stall = 0;

#if PROBE_STORE
    { unsigned char* dst = ws + WS_R;
      const int fr_ = lane & 15, fq_ = lane >> 4, wr_ = wave >> 2, wc_ = wave & 3;
      const u32x4 val = {(unsigned)tid, 1u, 2u, 3u};
      for (int rnd = 0; rnd < 8; ++rnd) {
        for (int m = 0; m < 8; ++m) {
          const unsigned row = (unsigned)(pm_ * PR + 128 * wr_ + 16 * m), colb = (unsigned)((4 * q_ + (rnd & 3)) * 512 + 128 * wc_);
          if (PROBE_STORE == 2) { const unsigned r0 = row + (lane >> 3), cb_ = colb + 16 * (lane & 7);
            *(GAS u32x4*)(dst + (size_t)r0 * 8192 + cb_) = val; *(GAS u32x4*)(dst + (size_t)(r0 + 8) * 8192 + cb_) = val; }
          else if (PROBE_STORE == 3) { GAS u32x4* p_ = (GAS u32x4*)(dst + (size_t)(row + fr_) * 8192 + colb + 32 * fq_); __builtin_nontemporal_store(val, p_); __builtin_nontemporal_store(val, p_ + 1); }
          else { GAS u32x4* p_ = (GAS u32x4*)(dst + (size_t)(row + fr_) * 8192 + colb + 32 * fq_); p_[0] = val; p_[1] = val; }
        }
        asm volatile("s_waitcnt vmcnt(0)" ::: "memory"); __syncthreads();
      } }
#endif
#if PROBE_MFMAONLY
    if (PROBE_MFMAONLY == 1 || wave < 4) { f32x4 d_[8]; bf16x8 a_, b_;
#pragma unroll
      for (int i = 0; i < 8; ++i) d_[i] = (f32x4){0.f, 0.f, 0.f, 0.f};
#pragma unroll
      for (int i = 0; i < 8; ++i) { a_[i] = (short)(tid + i); b_[i] = (short)(lane * 3 + i); }
#pragma unroll 1
      for (int it = 0; it < 64 * 68 / 8; ++it) {
#pragma unroll
          for (int i = 0; i < 8; ++i) d_[i] = __builtin_amdgcn_mfma_f32_16x16x32_bf16(a_, b_, d_[i], 0, 0, 0);
      }
      asm volatile("" :: "v"(d_[0]), "v"(d_[1]), "v"(d_[2]), "v"(d_[3]), "v"(d_[4]), "v"(d_[5]), "v"(d_[6]), "v"(d_[7])); }
    __syncthreads();
#endif
    for (int rep = 0; rep < 1 + (PROBE_PH == 6 ? PROBE_REPS : 0); ++rep) {
    if (rep) xcd_barrier(bar);
    if ((PH_EN & 1) && IN(0)) {
        for (int R = 4 * gw; R < MT; R += 4 * NGW) {
            f32x4 v[4][4];
#pragma unroll
            for (int r = 0; r < 4; ++r) { const GAS f32x4* xr = (const GAS f32x4*)x_row(x_prompt, x_sample, R + r) + lane;
#pragma unroll
                for (int j = 0; j < 4; ++j) v[r][j] = xr[64 * j]; }
#pragma unroll
            for (int r = 0; r < 4; ++r) { float s = 0.f;
#pragma unroll
                for (int j = 0; j < 4; ++j) s += (v[r][j].x * v[r][j].x + v[r][j].y * v[r][j].y) + (v[r][j].z * v[r][j].z + v[r][j].w * v[r][j].w);
                s = wave_sum(s);
                const int pmr = (R + r) / PR, lrr = (R + r) - pmr * PR;
#pragma unroll
                for (int j = 0; j < 4; ++j) *(GAS u32x2*)(hA + ablk(pmr, lrr, 4 * (lane + 64 * j), 16)) = (u32x2){cvt_pk_bf16(v[r][j].x, v[r][j].y), cvt_pk_bf16(v[r][j].z, v[r][j].w)};
                if (lane < NSLOT) ssq0[(size_t)(R + r) * NSLOT + lane] = (lane == 0) ? s : 0.f; }
        }
        for (int i0 = 8 * gw; i0 < 2 * MT; i0 += 8 * NGW) {
            f32x4 v[8];
#pragma unroll
            for (int r = 0; r < 8; ++r) { const int idx = i0 + r; const int l = idx / MT, R = idx - l * MT, pmr = R / PR, i = R - pmr * PR;
                const float* sp = i < 256 ? p_prompt + ((size_t)l * MP + 256 * pmr + i) * PLE : p_sample + ((size_t)l * MS + 16 * pmr + i - 256) * PLE;
                v[r] = ((const GAS f32x4*)sp)[lane]; }
#pragma unroll
            for (int r = 0; r < 8; ++r) { const int idx = i0 + r; const int l = idx / MT, R = idx - l * MT, pmr = R / PR, lrr = R - pmr * PR;
                *(GAS u32x2*)(pb + (size_t)l * MT * PLE + ablk(pmr, lrr, 4 * lane, 4)) = (u32x2){cvt_pk_bf16(v[r].x, v[r].y), cvt_pk_bf16(v[r].z, v[r].w)}; }
        }
        {
            LAS float* scr = (LAS float*)(lds + wave * 16640);
            constexpr int I_IN = 16 * 32, I_OUT = 8 * 16, I_UP = 16 * 64, I_DN = 64 * 16, I_G = 16 * 16, I_P = 4 * 16, I_L = I_IN + I_OUT + I_UP + I_DN + I_G + I_P;
            for (int it = gw; it < DEPTH * I_L; it += NGW) {
                const int l = it / I_L; int r = it - l * I_L; unsigned char* wl = ws + WS_W + (size_t)l * W_LAYER;
                if (r < I_IN) { const int kb = r / 32, nb = r % 32; transpose64(w_in + (size_t)l * D * INC, INC, norm_mix + l * D, (bf16*)(wl + W_IN), D, 64 * kb, 64 * nb, scr, lane); continue; } r -= I_IN;
                if (r < I_OUT) { const int kb = 8 + r / 16, nb = r % 16; transpose64(w_out + (size_t)l * D * D, D, nullptr, (bf16*)(wl + W_OUT), D, 64 * kb, 64 * nb, scr, lane); continue; } r -= I_OUT;
                if (r < I_UP) { const int kb = r / 64, nb = r % 64; transpose64(w_up + (size_t)l * D * DFF, DFF, norm_mlp + l * D, (bf16*)(wl + W_UP), D, 64 * kb, 64 * nb, scr, lane); continue; } r -= I_UP;
                if (r < I_DN) { const int kb = r / 16, nb = r % 16; transpose64(w_down + (size_t)l * DFF * D, D, nullptr, (bf16*)(wl + W_DN), DFF, 64 * kb, 64 * nb, scr, lane); continue; } r -= I_DN;
                if (r < I_G) { const int kb = r / 16, nb = r % 16; transpose64(w_ple_gate + (size_t)l * D * D, D, norm_ple + l * D, (bf16*)(wl + W_G), D, 64 * kb, 64 * nb, scr, lane); continue; } r -= I_G;
                { const int kb = r / 16, nb = r % 16; transpose64(w_ple_proj + (size_t)l * PLE * D, D, nullptr, (bf16*)(wl + W_P), PLE, 64 * kb, 64 * nb, scr, lane); }
            }
        }
        for (int it = gw; it < DEPTH * 4 * 64 * 4; it += NGW) {
            const int nb = it & 3, k2 = (it >> 2) & 63, g = (it >> 8) & 3, l = it >> 10;
            const float* pw0 = pool_w + ((size_t)(l * 4 + g) * 128 + 2 * k2) * 128; const float* sc = pool_scale + l * PW + 128 * g;
            const GAS f32x4* wo = (const GAS f32x4*)(w_out + ((size_t)l * D + 128 * g) * D + 256 * nb) + lane;
            f32x4 a0 = {0.f, 0.f, 0.f, 0.f}, a1 = {0.f, 0.f, 0.f, 0.f};
#pragma unroll 8
            for (int c = 0; c < 128; ++c) { const f32x4 w = wo[(size_t)c * (D / 4)] * sc[c]; a0 += w * pw0[c]; a1 += w * pw0[128 + c]; }
            GAS f32x4* fo = (GAS f32x4*)(fold + ((size_t)l * 512 + 128 * g + 2 * k2) * D + 256 * nb) + lane;
            fo[0] = a0; fo[D / 4] = a1;
        }
        __syncthreads();
    } }
    SEAM(1);
    if (PROBE_PH == 8) for (int rep = 0; rep < PROBE_REPS; ++rep) xcd_barrier(bar);

    if ((PH_EN & 2) && IN(2)) {
        if (wave == 7) { int vc = vcu; LAUNDER_S(vc); const int ly = vc >> 7, r = vc & 127, kb = r >> 4, nb = r & 15;
            transpose64((const float*)(ws + WS_FOLD) + (size_t)ly * 512 * D, D, nullptr, (bf16*)(ws + WS_W + (size_t)ly * W_LAYER + W_OUT), D, 64 * kb, 64 * nb, (LAS float*)(lds + RSTD_OFF + 1280), lane); }
    }
#pragma unroll 1
    for (int l = 0; l < DEPTH; ++l) {
        const int p0 = 2 + 6 * l;
        int pm = pm_; int q = q_;
        const unsigned char* wl = ws + WS_W + (size_t)l * W_LAYER;
        const bf16* hin = (l == 0) ? hA : hB;
        float* ssA = (l == 0) ? ssq0 : ssq1;
        float* ssB = (l == 0) ? ssq1 : ssq0;
        for (int rep = 0; rep < 1 + (PROBE_PH == 0 ? PROBE_REPS : 0); ++rep) {
        if (rep) xcd_barrier(bar);
        if (LY_EN(0) && IN(p0 + 0)) { LAUNDER_S(pm); LAUNDER_S(q);
            SrcPlain S{(const unsigned char*)(hin + (size_t)pm * PR * D), wl + W_IN, 16, 2 * q, 2, ((pm & 7) + 2 * q) & 7};
            panel_rstd(lds, ssA, pm, tid);
            PostScale<0> P{lds, proj, INC, pm, 2 * q, 16, 0, 0};
            gemm_stream(lds, S, P, 32, wave, lane, stall);
        } }
        SEAM(p0 + 0);
        for (int rep = 0; rep < 1 + (PROBE_PH == 1 ? PROBE_REPS : 0); ++rep) {
        if (rep) xcd_barrier(bar);
        if (LY_EN(1) && IN(p0 + 1)) { LAUNDER_S(pm); LAUNDER_S(q);
            MixCtx M{proj, mixA, state_pool, state_conv, conv_w, conv_b, out + O_NPP, out + O_NCP, out + O_NPS, out + O_NCS, l};
            int tidm = tid; LAUNDER_V(tidm);
            mix_prompt(M, pm, q, tidm);
            if (q < 2) mix_sample(M, pm, q, tidm);
        } }
        SEAM(p0 + 1);
        for (int rep = (PROBE_PH == 2 ? PROBE_REPS : 0); rep >= 0; --rep) {
        if (LY_EN(2) && IN(p0 + 2)) { LAUNDER_S(pm); LAUNDER_S(q);
            SrcPlain S{(const unsigned char*)(mixA + (size_t)pm * PR * D), wl + W_OUT, 16, q, 1, ((pm & 7) + 2 * q) & 7};
            PostRes P{hin, rep ? (bf16*)out : hA, rep ? (float*)out + 9000000 : ssB, pm, q, 16, 0};
            gemm_stream(lds, S, P, 16, wave, lane, stall);
        }
        if (rep) xcd_barrier(bar); }
        SEAM(p0 + 2);
        for (int rep = 0; rep < 1 + (PROBE_PH == 3 ? PROBE_REPS : 0); ++rep) {
        if (rep) xcd_barrier(bar);
        if (LY_EN(3) && IN(p0 + 3)) { LAUNDER_S(pm); LAUNDER_S(q);
            SrcPlain S{(const unsigned char*)(hA + (size_t)pm * PR * D), wl + W_UP, 16, 4 * q, 4, ((pm & 7) + 2 * q) & 7};
            panel_rstd(lds, ssB, pm, tid);
            PostScale<1> P{lds, fbuf, DFF, pm, 4 * q, 16, 0, 0};
            if (rep == 0) gemm_stream(lds, S, P, 64, wave, lane, stall); else gemm_stream<(PROBE_DRY == 5) ? 0 : PROBE_DRY>(lds, S, P, 64, wave, lane, stall);
        } }
        SEAM(p0 + 3);
        for (int rep = (PROBE_PH == 4 ? PROBE_REPS : 0); rep >= 0; --rep) {
        if (LY_EN(4) && IN(p0 + 4)) { LAUNDER_S(pm); LAUNDER_S(q);
            SrcPlain S{(const unsigned char*)(fbuf + (size_t)pm * PR * DFF), wl + W_DN, 64, q, 1, ((pm & 7) + 2 * q) & 7};
            PostRes P{hA, rep ? (bf16*)out : hA, rep ? (float*)out + 9000000 : ssA, pm, q, 64, 0};
            gemm_stream(lds, S, P, 64, wave, lane, stall);
        }
        if (rep) xcd_barrier(bar); }
        SEAM(p0 + 4);
        for (int rep = 0; rep < 1 + (PROBE_PH == 5 ? PROBE_REPS : 0); ++rep) {
        if (rep) xcd_barrier(bar);
        if (LY_EN(5) && IN(p0 + 5)) { LAUNDER_S(pm); LAUNDER_S(q);
            SrcPle S{(const unsigned char*)(pb + ((size_t)l * MT + (size_t)pm * PR) * PLE), wl + W_P + (size_t)q * 4 * BBLK,
                     (const unsigned char*)(hA + (size_t)pm * PR * D), wl + W_G + (size_t)q * 16 * BBLK, ((pm & 7) + 2 * q) & 7};
            panel_rstd(lds, ssA, pm, tid);
            PostPle P{lds, hA, hB, ssB, stash, pm, q};
            gemm_stream(lds, S, P, 20, wave, lane, stall);
        } }
        SEAM(p0 + 5);
    }
    for (int rep = 0; rep < 1 + (PROBE_PH == 7 ? PROBE_REPS : 0); ++rep) {
    if (rep) xcd_barrier(bar);
    if ((PH_EN & 0x4000) && IN(14)) {
        f32x4 gv[4];
#pragma unroll
        for (int j = 0; j < 4; ++j) gv[j] = ((const GAS f32x4*)norm_f)[lane * 2 + (j & 1) + 128 * (j >> 1)];
        {
            u32x4 ha[9], hbq[9];
#pragma unroll
            for (int k = 0; k < 9; ++k) { int R = gw + k * NGW; R = R < MT ? R : MT - 1; const int pmr = R / PR, i = R - pmr * PR;
                ha[k] = *(const GAS u32x4*)(hB + ablk(pmr, i, 8 * lane, 16)); hbq[k] = *(const GAS u32x4*)(hB + ablk(pmr, i, 512 + 8 * lane, 16)); }
#pragma unroll
            for (int k = 0; k < 9; ++k) { const int R = gw + k * NGW;
                const u32x4 a = ha[k], b = hbq[k];
                float v[16] = {bf_lo(a.x), bf_hi(a.x), bf_lo(a.y), bf_hi(a.y), bf_lo(a.z), bf_hi(a.z), bf_lo(a.w), bf_hi(a.w),
                               bf_lo(b.x), bf_hi(b.x), bf_lo(b.y), bf_hi(b.y), bf_lo(b.z), bf_hi(b.z), bf_lo(b.w), bf_hi(b.w)};
                float s = 0.f;
#pragma unroll
                for (int kk = 0; kk < 16; ++kk) s += v[kk] * v[kk];
                s = wave_sum(s);
                const float rs = __builtin_amdgcn_rsqf(s * (1.0f / D) + EPS);
                if (R < MT) { const int pmr = R / PR, i = R - pmr * PR;
                    float* dst = i < 256 ? out + O_YP + (size_t)(256 * pmr + i) * D : out + O_YS + (size_t)(16 * pmr + i - 256) * D;
                    GAS f32x4* o = (GAS f32x4*)dst;
                    o[lane * 2 + 0] = (f32x4){v[0] * rs * gv[0].x, v[1] * rs * gv[0].y, v[2] * rs * gv[0].z, v[3] * rs * gv[0].w};
                    o[lane * 2 + 1] = (f32x4){v[4] * rs * gv[1].x, v[5] * rs * gv[1].y, v[6] * rs * gv[1].z, v[7] * rs * gv[1].w};
                    o[128 + lane * 2 + 0] = (f32x4){v[8] * rs * gv[2].x, v[9] * rs * gv[2].y, v[10] * rs * gv[2].z, v[11] * rs * gv[2].w};
                    o[128 + lane * 2 + 1] = (f32x4){v[12] * rs * gv[3].x, v[13] * rs * gv[3].y, v[14] * rs * gv[3].z, v[15] * rs * gv[3].w}; }
            }
        }
    } }
#if PROBE_XCC
    { unsigned* xw = (unsigned*)(ws + WS_CTL + 40960);
      if (tid == 0) { const unsigned me = xb_xcc_id() + 1u; const unsigned old_ = atomicCAS(xw + (bx & 7), 0u, me); if (old_ != 0u && old_ != me) atomicAdd(xw + 8, 1u); }
      xcd_barrier(bar);
      if (bx == 0 && wave == 0) { const unsigned bad = __hip_atomic_load(xw + 8, __ATOMIC_RELAXED, __HIP_MEMORY_SCOPE_AGENT);
        if (bad) { const unsigned long long t0_ = rstamp(); while (rstamp() - t0_ < 40000ull) __builtin_amdgcn_s_sleep(8); } } }
#endif
#if PROBE_STALL >= 11
    if (bx == 0 && wave == ((PROBE_STALL == 12) ? 4 : 0)) { const unsigned long long t0_ = rstamp(); while (rstamp() - t0_ < stall) __builtin_amdgcn_s_sleep(8); }
#elif PROBE_STALL >= 9
    if (bx == 0 && wave == 0) { const unsigned long long tgt = (PROBE_STALL == 9) ? stall : stall / 24; const unsigned long long t0_ = rstamp(); while (rstamp() - t0_ < tgt) __builtin_amdgcn_s_sleep(8); }
#elif PROBE_STALL >= 6 && PROBE_STALL <= 8
    { unsigned long long* red = (unsigned long long*)(ws + WS_CTL + 32768);
      if (lane == 0 && wave == ((PROBE_STALL == 8) ? 4 : 0)) { if (PROBE_STALL == 7) atomicMax(red, ~stall); else atomicMax(red, stall); }
      xcd_barrier(bar);
      if (bx == 0 && wave == 0) { unsigned long long tgt = __hip_atomic_load(red, __ATOMIC_RELAXED, __HIP_MEMORY_SCOPE_AGENT); if (PROBE_STALL == 7) tgt = ~tgt;
        const unsigned long long t0_ = tstamp(); while (tstamp() - t0_ < tgt) __builtin_amdgcn_s_sleep(8); } }
#elif PROBE_STALL
    if (bx == 0 && wave == 0) { const unsigned long long t0_ = tstamp(); while (tstamp() - t0_ < stall) __builtin_amdgcn_s_sleep(8); }
#endif
#undef IN
#undef SEAM
}

extern "C" void kernel_launch(void* const* d_in, const int* in_sizes, int n_in, void* d_out, int out_size, void* d_ws, size_t ws_size, hipStream_t stream) {
    static int ready = 0;
    if (ready == 0) {
        if (n_in != 20 || out_size != (int)O_END || ws_size < WS_END) { fprintf(stderr, "kernel_launch: unexpected shapes (n_in %d out %d ws %zu)\n", n_in, out_size, ws_size); ready = -1; return; }
        if (hipFuncSetAttribute((const void*)fwd_kernel, hipFuncAttributeMaxDynamicSharedMemorySize, LDS_BYTES) != hipSuccess) { fprintf(stderr, "kernel_launch: hipFuncSetAttribute failed\n"); ready = -1; return; }
        ready = 1;
    }
    if (ready < 0) return;
    (void)in_sizes;
    (void)hipMemsetAsync((char*)d_ws + WS_CTL, 0, CTL_BYTES, stream);
    Args a{};
    for (int i = 0; i < 20; ++i) a.in[i] = (const float*)d_in[i];
    a.out = (float*)d_out; a.ws = (unsigned char*)d_ws;
#if N_LAUNCH_MODE == 1
    a.ph_lo = 0; a.ph_hi = NPHASE;
    hipLaunchKernelGGL(fwd_kernel, dim3(256), dim3(512), LDS_BYTES, stream, a);
#else
    for (int p = 0; p < NPHASE; ++p) { a.ph_lo = p; a.ph_hi = p + 1; hipLaunchKernelGGL(fwd_kernel, dim3(256), dim3(512), LDS_BYTES, stream, a); }
#endif
}
```

```cpp
#include <hip/hip_runtime.h>
#include <cstdio>
#include <cstdint>

#ifndef PROBE_PH
#define PROBE_PH -1
#endif
#ifndef PROBE_MFMA2
#define PROBE_MFMA2 0
#endif
#ifndef PROBE_LOAD2
#define PROBE_LOAD2 0
#endif
#ifndef PROBE_STALL
#define PROBE_STALL 0
#endif
#ifndef PROBE_LDS2
#define PROBE_LDS2 0
#endif
#ifndef PROBE_MFMAONLY
#define PROBE_MFMAONLY 0
#endif
#ifndef PROBE_XCC
#define PROBE_XCC 0
#endif
#ifndef PROBE_DRY
#define PROBE_DRY 0
#endif
#ifndef PROBE_STORE
#define PROBE_STORE 0
#endif
#ifndef PROBE_EPI
#define PROBE_EPI 0
#endif
#ifndef SKEW_UNITS
#define SKEW_UNITS 0
#endif
#ifndef NT_WEIGHTS
#define NT_WEIGHTS 0
#endif
#ifndef PROBE_REPS
#define PROBE_REPS 0
#endif
#ifndef N_LAUNCH_MODE
#define N_LAUNCH_MODE 1
#endif

#define LAS __attribute__((address_space(3)))
#define GAS __attribute__((address_space(1)))
typedef unsigned short bf16;
typedef short bf16x8 __attribute__((ext_vector_type(8)));
typedef float f32x4 __attribute__((ext_vector_type(4)));
typedef float f32x2 __attribute__((ext_vector_type(2)));
typedef unsigned u32x4 __attribute__((ext_vector_type(4)));
typedef unsigned u32x2 __attribute__((ext_vector_type(2)));

constexpr int D = 1024, SEQ = 2048, NB = 8, DB = 128, DS = 8, DEPTH = 2, PW = 512, CW = 512, DFF = 4096, PLE = 256, INC = 2048;
constexpr int MP = NB * SEQ, MS = DB * DS, MT = MP + MS;
constexpr int NPAN = 64, PR = 272;
constexpr float EPS = 1e-6f;
constexpr int NPHASE = 15;

constexpr size_t O_YP = 0, O_YS = O_YP + (size_t)MP * D, O_NPP = O_YS + (size_t)MS * D, O_NCP = O_NPP + (size_t)DEPTH * NB * 15 * PW,
                 O_NPS = O_NCP + (size_t)DEPTH * NB * 2 * CW, O_NCS = O_NPS + (size_t)DEPTH * DB * 15 * PW, O_END = O_NCS + (size_t)DEPTH * DB * 2 * CW;

constexpr size_t MiB = 1u << 20;
constexpr size_t WS_CTL = 0, CTL_BYTES = 64 * 1024;
constexpr int NSLOT = 32;
constexpr size_t WS_SSQ0 = 1 * MiB, SSQ_BYTES = (size_t)MT * NSLOT * 4;
constexpr size_t WS_SSQ1 = WS_SSQ0 + 2 * MiB + 256 * 1024;
constexpr size_t WS_FOLD = 6 * MiB;
constexpr size_t WS_W = 10 * MiB;
constexpr size_t W_IN = 0, W_OUT = 4 * MiB, W_UP = 6 * MiB, W_DN = 14 * MiB, W_G = 22 * MiB, W_P = 24 * MiB, W_LAYER = 24 * MiB + 512 * 1024;
constexpr size_t WS_HA = WS_W + 2 * W_LAYER;
constexpr size_t WS_PB = WS_HA + 34 * MiB;
constexpr size_t WS_R = WS_PB + 17 * MiB;
constexpr size_t R_PROJ = 0, R_MIX = 68 * MiB, R_HB = 102 * MiB, R_F = 0, R_STASH = 0;
constexpr size_t WS_END = WS_R + 136 * MiB;
static_assert(WS_END <= 256 * MiB, "ws map");
static_assert((size_t)MT * D * 2 == 34 * MiB && (size_t)MT * DFF * 2 == 136 * MiB && (size_t)MT * INC * 2 == 68 * MiB, "sizes");

constexpr int SUBT = 1024;
constexpr int A_SUBS = 17, B_SUBS = 16, STAGE_BYTES = (A_SUBS + B_SUBS) * SUBT;
constexpr int NSLOTS = 4;
constexpr int MISC_OFF = NSLOTS * STAGE_BYTES;
constexpr int RSTD_OFF = MISC_OFF + 1024;
constexpr int LDS_BYTES = RSTD_OFF + 1280 + 16640;

#define VM_WAIT() asm volatile("s_waitcnt vmcnt(0)" ::: "memory")
#define LGKM_WAIT() asm volatile("s_waitcnt lgkmcnt(0)" ::: "memory")
#define LAUNDER_V(x_) asm volatile("" : "+v"(x_))
#define LAUNDER_S(x_) asm volatile("" : "+s"(x_))
__device__ __forceinline__ unsigned long long tstamp() { unsigned long long t; asm volatile("s_memtime %0\n\ts_waitcnt lgkmcnt(0)" : "=s"(t) :: "memory"); return t; }
__device__ __forceinline__ unsigned long long rstamp() { unsigned long long t; asm volatile("s_memrealtime %0\n\ts_waitcnt lgkmcnt(0)" : "=s"(t) :: "memory"); return t; }
#define BAR() do { asm volatile("" ::: "memory"); __builtin_amdgcn_s_barrier(); asm volatile("" ::: "memory"); } while (0)
__device__ __forceinline__ unsigned cvt_pk_bf16(float lo, float hi) { unsigned r; asm volatile("v_cvt_pk_bf16_f32 %0, %1, %2" : "=v"(r) : "v"(lo), "v"(hi)); return r; }
__device__ __forceinline__ float bf_lo(unsigned u) { return __builtin_bit_cast(float, u << 16); }
__device__ __forceinline__ float bf_hi(unsigned u) { return __builtin_bit_cast(float, u & 0xffff0000u); }
__device__ __forceinline__ float wave_sum(float v) {
#pragma unroll
    for (int o = 1; o < 64; o <<= 1) v += __shfl_xor(v, o);
    return v;
}

#define XB_TMO      128
#define XB_XCNT(j)  (256  + 64 * (j))
#define XB_XSUB(j)  (1280 + 64 * (j))
#define XB_XGEN(j)  (2304 + 64 * (j))
#define XB_TOP      3328
#define XB_TOPGEN   3392
#define XCD_BAR_WORDS 3456
#define XB_SPIN_CAP (1u << 18)
__device__ __forceinline__ unsigned xb_ld(unsigned* p)              { return __hip_atomic_load(p, __ATOMIC_RELAXED, __HIP_MEMORY_SCOPE_AGENT); }
__device__ __forceinline__ unsigned xb_add(unsigned* p, unsigned v) { return __hip_atomic_fetch_add(p, v, __ATOMIC_RELAXED, __HIP_MEMORY_SCOPE_AGENT); }
__device__ __forceinline__ unsigned xb_xcc_id() { return (unsigned)__builtin_amdgcn_s_getreg((3 << 11) | 20) & 0xFu; }
#define XB_SPIN(cond, bar) do { unsigned _sp = 0; while (cond) { __builtin_amdgcn_s_sleep(1); \
    if ((++_sp & 255u) == 0u) { if (xb_ld(&(bar)[XB_TMO])) break; if (_sp > XB_SPIN_CAP) { atomicAdd(&(bar)[XB_TMO], 1u); break; } } } } while (0)
struct XcdBarrier { unsigned* bar; unsigned x; volatile LAS unsigned* st; };
__device__ __forceinline__ XcdBarrier xcd_barrier_post(unsigned* bar, volatile LAS unsigned* st) {
    XcdBarrier b; b.bar = bar; b.x = xb_xcc_id(); b.st = st;
    if (threadIdx.x == 0) (void)xb_add(&bar[XB_XCNT(b.x)], 1u);
    return b;
}
__device__ __forceinline__ void xcd_barrier_complete(unsigned* bar, unsigned x, unsigned& nloc, unsigned& nx) {
    const unsigned G = gridDim.x * gridDim.y * gridDim.z;
    unsigned sum, cnt, mine, sp = 0u;
    for (;;) {
        sum = 0u; cnt = 0u; mine = 0u;
#pragma unroll
        for (unsigned j = 0; j < 16; ++j) { const unsigned c = xb_ld(&bar[XB_XCNT(j)]); sum += c; cnt += (c > 0u) ? 1u : 0u; mine = (j == x) ? c : mine; }
        if (sum == G) break;
        __builtin_amdgcn_s_sleep(1);
        if ((++sp & 255u) == 0u) { if (xb_ld(&bar[XB_TMO])) break; if (sp > XB_SPIN_CAP) { atomicAdd(&bar[XB_TMO], 1u); break; } }
    }
    nloc = mine > 0u ? mine : 1u; nx = cnt > 0u ? cnt : 1u;
}
__device__ __forceinline__ void xcd_barrier(const XcdBarrier& b) {
    asm volatile("s_waitcnt vmcnt(0)" ::: "memory");
    __syncthreads();
    if (threadIdx.x == 0) {
        unsigned* bar = b.bar;
        __builtin_amdgcn_s_waitcnt(0);
        unsigned nloc = b.st[0], nx = b.st[1];
        if (nloc == 0u) { xcd_barrier_complete(bar, b.x, nloc, nx); b.st[0] = nloc; b.st[1] = nx; }
        const unsigned old = xb_add(&bar[XB_XSUB(b.x)], 1u);
        const unsigned gen = old / nloc;
        if (old + 1u == (gen + 1u) * nloc) {
            __builtin_amdgcn_fence(__ATOMIC_RELEASE, "agent");
            asm volatile("s_waitcnt vmcnt(0)" ::: "memory");
            const unsigned og = xb_add(&bar[XB_TOP], 1u);
            const unsigned tg = og / nx;
            if (og + 1u == (tg + 1u) * nx) xb_add(&bar[XB_TOPGEN], 1u);
            else XB_SPIN(xb_ld(&bar[XB_TOPGEN]) == tg, bar);
            __builtin_amdgcn_fence(__ATOMIC_ACQUIRE, "agent");
            xb_add(&bar[XB_XGEN(b.x)], 1u);
            asm volatile("s_waitcnt vmcnt(0)" ::: "memory");
        } else {
            XB_SPIN(xb_ld(&bar[XB_XGEN(b.x)]) == gen, bar);
            __builtin_amdgcn_fence(__ATOMIC_ACQUIRE, "agent");
            asm volatile("s_waitcnt vmcnt(0)" ::: "memory");
        }
    }
    __syncthreads();
}

struct Args { const float* in[20]; float* out; unsigned char* ws; int ph_lo, ph_hi; };


__device__ __forceinline__ void glds16s(unsigned voff, unsigned long long sbase, unsigned slot, unsigned ldsoff) {
    asm volatile("s_add_u32 m0, %2, %3\n\ts_nop 0\n\tglobal_load_lds_dwordx4 %0, %1" :: "v"(voff), "s"(sbase), "s"(slot), "s"(ldsoff) : "memory", "m0", "scc");
}
__device__ __forceinline__ void glds16s_nt(unsigned voff, unsigned long long sbase, unsigned slot, unsigned ldsoff) {
#if NT_WEIGHTS
    asm volatile("s_add_u32 m0, %2, %3\n\ts_nop 0\n\tglobal_load_lds_dwordx4 %0, %1 nt" :: "v"(voff), "s"(sbase), "s"(slot), "s"(ldsoff) : "memory", "m0", "scc");
#else
    glds16s(voff, sbase, slot, ldsoff);
#endif
}
constexpr unsigned ABLK = PR * 128, BBLK = 256 * 128;
__device__ __forceinline__ unsigned ablk(int pm, int lr, int col, int KT) { return (unsigned)(((pm * KT + (col >> 6)) * PR + lr) * 64 + (col & 63)); }
struct Seg { unsigned long long a, b; int nsub; };

#define ISSUE_SUB(slotoff_) do { const unsigned so_ = (unsigned)(unsigned long long)(lds + (slotoff_)); \
    glds16s(voA0, ca, so_, lA0); glds16s(voA1, ca, so_, lA0 + 8 * SUBT); glds16s_nt(voB0, cbp, so_, lB0); glds16s_nt(voB1, cbp, so_, lB0 + 8 * SUBT); \
    if (wave == 0) glds16s(voX, ca, so_, 16 * SUBT); \
    ca += cpar ? (ABLK - 64) : 64; cbp += cpar ? (BBLK - 64) : 64; cpar ^= 1; \
    if (--cleft == 0) { ck = (ck + 1 < S.nseg()) ? ck + 1 : ck; cseg = S.seg(ck); ca = cseg.a; cbp = cseg.b; cleft = cseg.nsub; cpar = 0; } } while (0)

#define LDA(slotoff_, m_) (*(const LAS bf16x8*)(lds + (slotoff_) + aoff + (m_) * SUBT + rdoff))
#define LDAX(slotoff_)    (*(const LAS bf16x8*)(lds + (slotoff_) + 16 * SUBT + rdoff))
#define LDB(slotoff_, n_) (*(const LAS bf16x8*)(lds + (slotoff_) + boff + (n_) * SUBT + rdoff))
#define MFMA(a_, b_, c_) c_ = __builtin_amdgcn_mfma_f32_16x16x32_bf16(b_, a_, c_, 0, 0, 0)

struct Acc { f32x4 m[8][4]; f32x4 x[2]; };
__device__ __forceinline__ void zero_acc(Acc& a) {
#pragma unroll
    for (int m = 0; m < 8; ++m)
#pragma unroll
        for (int n = 0; n < 4; ++n) a.m[m][n] = (f32x4){0.f, 0.f, 0.f, 0.f};
    a.x[0] = (f32x4){0.f, 0.f, 0.f, 0.f}; a.x[1] = (f32x4){0.f, 0.f, 0.f, 0.f};
}

#define SB() __builtin_amdgcn_sched_barrier(0)
#define VMCNT_I(n_) asm volatile("s_waitcnt vmcnt(%0)" :: "i"(n_) : "memory")
template <int NST> __device__ __forceinline__ void ring_wait(int& epi_left, int wave) {
    if (epi_left > 0) { --epi_left; if (wave == 0) VMCNT_I(10 + NST); else VMCNT_I(8 + NST); }
    else { if (wave == 0) VMCNT_I(10); else VMCNT_I(8); }
}

template <int DRY = 0, class SRC, class POST>
__device__ __forceinline__ void gemm_stream(LAS unsigned char* lds, const SRC& S, POST& P, const int ntot, const int wave_in, const int lane_in, unsigned long long& stall) {
    int lane = lane_in; LAUNDER_V(lane); int wave = wave_in; LAUNDER_S(wave);
    const int fr = lane & 15, fq = lane >> 4, wr = wave >> 2, wc = wave & 3;
    const unsigned rdoff = (unsigned)((fr * 64 + fq * 16) ^ ((fr >> 3) << 5));
    const int b16 = lane * 16, swz = b16 ^ (((b16 >> 9) & 1) << 5), rr = swz >> 6, cb = swz & 63, pr = 16 * (rr >> 2) + (rr & 3);
    const unsigned aoff = (unsigned)(8 * wr) * SUBT, boff = (unsigned)(A_SUBS + 4 * wc) * SUBT;
    const bool hi = (wr != 0);
    int epi_left = 0;
    Acc acc; zero_acc(acc);
    bf16x8 Bf[4], F[9];
    const int NS = 2 * ntot;
    int ck = 0; Seg cseg = S.seg(0); unsigned long long ca = cseg.a, cbp = cseg.b; int cleft = cseg.nsub; int cpar = 0;
    const unsigned voA0 = (unsigned)(16 * wave + rr) * 128u + (unsigned)cb, voA1 = voA0 + 128u * 128u, voX = (unsigned)(256 + rr) * 128u + (unsigned)cb;
    const unsigned voB0 = (unsigned)(64 * (wave >> 2) + 4 * (wave & 3) + pr) * 128u + (unsigned)cb, voB1 = voB0 + 128u * 128u;
    const unsigned lA0 = (unsigned)wave * SUBT, lB0 = (unsigned)(A_SUBS + wave) * SUBT;
    if (SKEW_UNITS > 0 && DRY == 0) { const int dly = S.skew(); for (int i = 0; i < dly; ++i) __builtin_amdgcn_s_sleep(SKEW_UNITS); }
    ISSUE_SUB(0); ISSUE_SUB(STAGE_BYTES); ISSUE_SUB(2 * STAGE_BYTES);
    ring_wait<0>(epi_left, wave);
    BAR();
    if (hi) BAR();
#if PROBE_STALL == 9 || PROBE_STALL == 10
    const unsigned long long tl0_ = (PROBE_STALL == 9) ? rstamp() : tstamp();
#elif PROBE_STALL >= 6 && PROBE_STALL <= 8
    const unsigned long long tl0_ = tstamp();
#endif
    bool pend = false;
#pragma unroll 1
    for (int s = 0; s < NS; ++s) {
        const unsigned cs = (unsigned)(s & 3) * STAGE_BYTES, rs = (unsigned)((s + 3) & 3) * STAGE_BYTES;
        SB();
        if (DRY == 0) { if (pend) { P.run(acc, wr, wc, fr, fq); pend = false; epi_left = 2; } }
        if (DRY != 1) {
#pragma unroll
        for (int n = 0; n < 4; ++n) Bf[n] = LDB(cs, n);
#pragma unroll
        for (int m = 0; m < 8; ++m) F[m] = LDA(cs, m);
        F[8] = LDAX(cs);
        }
        SB();
        ISSUE_SUB(rs);
        if (hi) ring_wait<POST::NST>(epi_left, wave);
        LGKM_WAIT();
        BAR();
        if (DRY != 1) {
#pragma unroll
        for (int m = 0; m < 8; ++m)
#pragma unroll
            for (int n = 0; n < 4; ++n) MFMA(F[m], Bf[n], acc.m[m][n]);
        { const bf16x8 bx0 = hi ? Bf[2] : Bf[0], bx1 = hi ? Bf[3] : Bf[1]; MFMA(F[8], bx0, acc.x[0]); MFMA(F[8], bx1, acc.x[1]); }
        }
        if (DRY == 0) { if ((s & 1) && P.due()) { if (hi) { P.run(acc, wr, wc, fr, fq); epi_left = 2; } else pend = true; } }
        if (!hi) ring_wait<POST::NST>(epi_left, wave);
        BAR();
    }
    if (DRY == 0) { if (pend) P.run(acc, wr, wc, fr, fq); }
    if (!hi) BAR();
    LGKM_WAIT(); VM_WAIT(); BAR();
}

__device__ __forceinline__ void panel_rstd(LAS unsigned char* lds, const float* ssq, int pm, int tid) {
    LAS float* rt = (LAS float*)(lds + RSTD_OFF);
    if (tid < PR) {
        const GAS f32x4* p = (const GAS f32x4*)(ssq + (size_t)(pm * PR + tid) * NSLOT);
        float s = 0.f;
#pragma unroll
        for (int i = 0; i < NSLOT / 4; ++i) { const f32x4 q = p[i]; s += (q.x + q.y) + (q.z + q.w); }
        rt[tid] = __builtin_amdgcn_rsqf(s * (1.0f / D) + EPS);
    }
    __syncthreads();
}
#define RSTD(r_) (((const LAS float*)(lds + RSTD_OFF))[r_])
__device__ __forceinline__ void store16(bf16* p, const float (&v)[16]) {
    u32x4 a, b;
    a.x = cvt_pk_bf16(v[0], v[1]); a.y = cvt_pk_bf16(v[2], v[3]); a.z = cvt_pk_bf16(v[4], v[5]); a.w = cvt_pk_bf16(v[6], v[7]);
    b.x = cvt_pk_bf16(v[8], v[9]); b.y = cvt_pk_bf16(v[10], v[11]); b.z = cvt_pk_bf16(v[12], v[13]); b.w = cvt_pk_bf16(v[14], v[15]);
    *(GAS u32x4*)p = a; *(GAS u32x4*)(p + 8) = b;
}
__device__ __forceinline__ void store8(bf16* p, const float (&v)[8]) {
    u32x4 a;
    a.x = cvt_pk_bf16(v[0], v[1]); a.y = cvt_pk_bf16(v[2], v[3]); a.z = cvt_pk_bf16(v[4], v[5]); a.w = cvt_pk_bf16(v[6], v[7]);
    *(GAS u32x4*)p = a;
}
__device__ __forceinline__ void load16(const bf16* p, float (&v)[16]) {
    const u32x4 a = *(const GAS u32x4*)p, b = *(const GAS u32x4*)(p + 8);
    v[0] = bf_lo(a.x); v[1] = bf_hi(a.x); v[2] = bf_lo(a.y); v[3] = bf_hi(a.y); v[4] = bf_lo(a.z); v[5] = bf_hi(a.z); v[6] = bf_lo(a.w); v[7] = bf_hi(a.w);
    v[8] = bf_lo(b.x); v[9] = bf_hi(b.x); v[10] = bf_lo(b.y); v[11] = bf_hi(b.y); v[12] = bf_lo(b.z); v[13] = bf_hi(b.z); v[14] = bf_lo(b.w); v[15] = bf_hi(b.w);
}
__device__ __forceinline__ void load8(const bf16* p, float (&v)[8]) {
    const u32x4 a = *(const GAS u32x4*)p;
    v[0] = bf_lo(a.x); v[1] = bf_hi(a.x); v[2] = bf_lo(a.y); v[3] = bf_hi(a.y); v[4] = bf_lo(a.z); v[5] = bf_hi(a.z); v[6] = bf_lo(a.w); v[7] = bf_hi(a.w);
}

struct SrcPlain {
    const unsigned char* A; const unsigned char* B; int nt, pn0, nu; int sk;
    __device__ __forceinline__ int skew() const { return sk; }
    __device__ __forceinline__ int nseg() const { return nu; }
    __device__ __forceinline__ Seg seg(int u) const { Seg r; r.a = (unsigned long long)A; r.b = (unsigned long long)(B + (size_t)(pn0 + u) * nt * BBLK); r.nsub = 2 * nt; return r; }
};
struct SrcPle {
    const unsigned char* Ap; const unsigned char* Bp; const unsigned char* Ah; const unsigned char* Bg; int sk;
    __device__ __forceinline__ int skew() const { return sk; }
    __device__ __forceinline__ int nseg() const { return 2; }
    __device__ __forceinline__ Seg seg(int k) const { Seg r;
        if (k == 0) { r.a = (unsigned long long)Ap; r.b = (unsigned long long)Bp; r.nsub = 8; }
        else { r.a = (unsigned long long)Ah; r.b = (unsigned long long)Bg; r.nsub = 32; }
        return r; }
};

template <int ACT>
struct PostScale {
    static constexpr int NST = 17;
    LAS unsigned char* lds; bf16* out; int ldo, pm, pn0, nt, tc, u; int mode = 0;
    static __device__ __forceinline__ float act(float x) { if (ACT == 1) { x = fmaxf(x, 0.f); x = x * x; } return x; }
    __device__ __forceinline__ bool due() { if (++tc < nt) return false; tc = 0; return true; }
    __device__ __forceinline__ void run(Acc& acc, int wr, int wc, int fr, int fq) {
        int lr0 = 128 * wr + fr; LAUNDER_V(lr0);
        const int KT = ldo >> 6;
        GAS unsigned char* ob = (GAS unsigned char*)out + 2u * (unsigned)(((pm * KT + (pn0 + u) * 4 + wc) * PR + lr0) * 64 + 16 * fq);
        float rsv[9];
#pragma unroll
        for (int m = 0; m < 8; ++m) rsv[m] = RSTD(lr0 + 16 * m);
        rsv[8] = RSTD(256 + (lr0 & 15));
#pragma unroll
        for (int m = 0; m < 8; ++m) { float v[16];
#pragma unroll
            for (int k = 0; k < 16; ++k) v[k] = act(acc.m[m][k >> 2][k & 3] * rsv[m]);
            store16((bf16*)(ob + (unsigned)(16 * m) * 128u), v); }
        { const int lrx = 256 + (lr0 & 15);
            float v[8];
#pragma unroll
            for (int k = 0; k < 8; ++k) v[k] = act(acc.x[k >> 2][k & 3] * rsv[8]);
            store8((bf16*)((GAS unsigned char*)out + 2u * (unsigned)(((pm * KT + (pn0 + u) * 4 + wc) * PR + lrx) * 64 + 16 * fq + 8 * wr)), v); }
        zero_acc(acc); ++u;
    }
};
struct PostRes {
    static constexpr int NST = 26;
    const bf16* hin; bf16* hout; float* ssq_out; int pm, pn, nt, tc;
    __device__ __forceinline__ bool due() { if (++tc < nt) return false; tc = 0; return true; }
    __device__ __forceinline__ void run(Acc& acc, int wr, int wc, int fr, int fq) {
        int row0 = pm * PR + 128 * wr + fr; LAUNDER_V(row0);
        const int lr0 = row0 - pm * PR;
        const unsigned eb = 2u * (unsigned)(((pm * 16 + pn * 4 + wc) * PR + lr0) * 64 + 16 * fq);
        const GAS unsigned char* ib = (const GAS unsigned char*)hin + eb; GAS unsigned char* ob = (GAS unsigned char*)hout + eb;
        float* sq = ssq_out + (unsigned)row0 * NSLOT + 8 * pn + 2 * wc;
        const int rowx = pm * PR + 256 + (lr0 - 128 * wr);
        const unsigned eox = 2u * (unsigned)(((pm * 16 + pn * 4 + wc) * PR + 256 + (lr0 - 128 * wr)) * 64 + 16 * fq + 8 * wr);
        u32x4 hv[8][2], hx;
#pragma unroll
        for (int m = 0; m < 6; ++m) { hv[m][0] = *(const GAS u32x4*)(ib + (unsigned)(16 * m) * 128u); hv[m][1] = *(const GAS u32x4*)(ib + (unsigned)(16 * m) * 128u + 16); }
#pragma unroll
        for (int m = 0; m < 8; ++m) { float v[16]; const u32x4 a = hv[m][0], b = hv[m][1];
            if (m == 1) {
#pragma unroll
                for (int m2 = 6; m2 < 8; ++m2) { hv[m2][0] = *(const GAS u32x4*)(ib + (unsigned)(16 * m2) * 128u); hv[m2][1] = *(const GAS u32x4*)(ib + (unsigned)(16 * m2) * 128u + 16); }
                hx = *(const GAS u32x4*)((const GAS unsigned char*)hin + eox);
                __builtin_amdgcn_sched_barrier(0); }
            v[0] = bf_lo(a.x); v[1] = bf_hi(a.x); v[2] = bf_lo(a.y); v[3] = bf_hi(a.y); v[4] = bf_lo(a.z); v[5] = bf_hi(a.z); v[6] = bf_lo(a.w); v[7] = bf_hi(a.w);
            v[8] = bf_lo(b.x); v[9] = bf_hi(b.x); v[10] = bf_lo(b.y); v[11] = bf_hi(b.y); v[12] = bf_lo(b.z); v[13] = bf_hi(b.z); v[14] = bf_lo(b.w); v[15] = bf_hi(b.w);
            float ss = 0.f;
#pragma unroll
            for (int k = 0; k < 16; ++k) { v[k] += acc.m[m][k >> 2][k & 3]; ss += v[k] * v[k]; }
            store16((bf16*)(ob + (unsigned)(16 * m) * 128u), v);
            ss += __shfl_xor(ss, 16); ss += __shfl_xor(ss, 32);
            if (fq == 0) *(GAS f32x2*)(sq + (unsigned)(16 * m) * NSLOT) = (f32x2){ss, 0.f}; }
        { float v[8]; v[0] = bf_lo(hx.x); v[1] = bf_hi(hx.x); v[2] = bf_lo(hx.y); v[3] = bf_hi(hx.y); v[4] = bf_lo(hx.z); v[5] = bf_hi(hx.z); v[6] = bf_lo(hx.w); v[7] = bf_hi(hx.w);
            float ss = 0.f;
#pragma unroll
            for (int k = 0; k < 8; ++k) { v[k] += acc.x[k >> 2][k & 3]; ss += v[k] * v[k]; }
            store8((bf16*)((GAS unsigned char*)hout + eox), v);
            ss += __shfl_xor(ss, 16); ss += __shfl_xor(ss, 32);
            if (fq == 0) ssq_out[(unsigned)rowx * NSLOT + 8 * pn + 2 * wc + wr] = ss; }
        zero_acc(acc);
    }
};
struct PostPle {
    static constexpr int NST = 17;
    LAS unsigned char* lds; const bf16* hin; bf16* hout; float* ssq_out; float* stash; int pm, pn;
    int g = -1, gdue = 0;
    __device__ __forceinline__ bool due() { ++g; if (g != 3 && g != 19) return false; gdue = g; return true; }
    __device__ __forceinline__ void run(Acc& acc, int wr, int wc, int fr, int fq) {
        const int g = gdue;
        int tid = (wr * 4 + wc) * 64 + fq * 16 + fr; LAUNDER_V(tid);
        GAS u32x4* st = (GAS u32x4*)stash + tid;
        if (g == 3) {
#pragma unroll
            for (int m = 0; m < 8; ++m)
#pragma unroll
                for (int hf = 0; hf < 2; ++hf) { u32x4 w; w.x = cvt_pk_bf16(acc.m[m][2 * hf][0], acc.m[m][2 * hf][1]); w.y = cvt_pk_bf16(acc.m[m][2 * hf][2], acc.m[m][2 * hf][3]);
                    w.z = cvt_pk_bf16(acc.m[m][2 * hf + 1][0], acc.m[m][2 * hf + 1][1]); w.w = cvt_pk_bf16(acc.m[m][2 * hf + 1][2], acc.m[m][2 * hf + 1][3]);
                    st[(2 * m + hf) * 512] = w; }
            { u32x4 w; w.x = cvt_pk_bf16(acc.x[0][0], acc.x[0][1]); w.y = cvt_pk_bf16(acc.x[0][2], acc.x[0][3]); w.z = cvt_pk_bf16(acc.x[1][0], acc.x[1][1]); w.w = cvt_pk_bf16(acc.x[1][2], acc.x[1][3]);
              st[16 * 512] = w; }
            zero_acc(acc);
        } else {
            int lr0 = 128 * wr + fr; LAUNDER_V(lr0);
            const int row0 = pm * PR + lr0;
            const unsigned eb = 2u * (unsigned)(((pm * 16 + pn * 4 + wc) * PR + lr0) * 64 + 16 * fq);
            const GAS unsigned char* ib = (const GAS unsigned char*)hin + eb; GAS unsigned char* ob = (GAS unsigned char*)hout + eb;
            float* sq = ssq_out + (unsigned)row0 * NSLOT + 8 * pn + 2 * wc;
#pragma unroll
            for (int m = 0; m < 8; ++m) { const int g16 = 16 * m; const float rs = RSTD(lr0 + g16);
                const unsigned o = (unsigned)g16 * 128u;
                float v[16], pp[16];
#pragma unroll
                for (int hf = 0; hf < 2; ++hf) { const u32x4 a = *(const GAS u32x4*)(ib + o + 16 * hf), p = st[(2 * m + hf) * 512];
                    v[8 * hf + 0] = bf_lo(a.x); v[8 * hf + 1] = bf_hi(a.x); v[8 * hf + 2] = bf_lo(a.y); v[8 * hf + 3] = bf_hi(a.y); v[8 * hf + 4] = bf_lo(a.z); v[8 * hf + 5] = bf_hi(a.z); v[8 * hf + 6] = bf_lo(a.w); v[8 * hf + 7] = bf_hi(a.w);
                    pp[8 * hf + 0] = bf_lo(p.x); pp[8 * hf + 1] = bf_hi(p.x); pp[8 * hf + 2] = bf_lo(p.y); pp[8 * hf + 3] = bf_hi(p.y); pp[8 * hf + 4] = bf_lo(p.z); pp[8 * hf + 5] = bf_hi(p.z); pp[8 * hf + 6] = bf_lo(p.w); pp[8 * hf + 7] = bf_hi(p.w); }
                float ss = 0.f;
#pragma unroll
                for (int k = 0; k < 16; ++k) { const float gt = 1.0f / (1.0f + __expf(-acc.m[m][k >> 2][k & 3] * rs)); v[k] += gt * pp[k]; ss += v[k] * v[k]; }
                store16((bf16*)(ob + o), v);
                ss += __shfl_xor(ss, 16); ss += __shfl_xor(ss, 32);
                if (fq == 0) *(GAS f32x2*)(sq + (unsigned)g16 * NSLOT) = (f32x2){ss, 0.f}; }
            { const int lrx = 256 + fr; const int rowx = pm * PR + lrx; const float rs = RSTD(lrx);
                const unsigned eo = 2u * (unsigned)(((pm * 16 + pn * 4 + wc) * PR + lrx) * 64 + 16 * fq + 8 * wr);
                float v[8], pp[8]; load8((const bf16*)((const GAS unsigned char*)hin + eo), v);
                { const u32x4 p = st[16 * 512]; pp[0] = bf_lo(p.x); pp[1] = bf_hi(p.x); pp[2] = bf_lo(p.y); pp[3] = bf_hi(p.y); pp[4] = bf_lo(p.z); pp[5] = bf_hi(p.z); pp[6] = bf_lo(p.w); pp[7] = bf_hi(p.w); }
                float ss = 0.f;
#pragma unroll
                for (int k = 0; k < 8; ++k) { const float gt = 1.0f / (1.0f + __expf(-acc.x[k >> 2][k & 3] * rs)); v[k] += gt * pp[k]; ss += v[k] * v[k]; }
                store8((bf16*)((GAS unsigned char*)hout + eo), v);
                ss += __shfl_xor(ss, 16); ss += __shfl_xor(ss, 32);
                if (fq == 0) ssq_out[(unsigned)rowx * NSLOT + 8 * pn + 2 * wc + wr] = ss; }
        }
    }
};

__device__ __forceinline__ const float* x_row(const float* xp, const float* xs, int R) { const int pm = R / PR, i = R - pm * PR;
    return i < 256 ? xp + (size_t)(256 * pm + i) * D : xs + (size_t)(16 * pm + i - 256) * D; }

__device__ __forceinline__ void transpose64(const float* W, int ldw, const float* gain, bf16* WT, int K, int k0, int n0, LAS float* scr, int lane) {
    const int kr = lane >> 4, nq = lane & 15;
    const GAS float* src = (const GAS float*)W + (size_t)(k0 + kr) * ldw + n0 + 4 * nq;
    f32x4 v[16];
#pragma unroll
    for (int i = 0; i < 16; ++i) v[i] = *(const GAS f32x4*)(src + (size_t)(4 * i) * ldw);
    if (gain) {
#pragma unroll
        for (int i = 0; i < 16; ++i) v[i] = v[i] * gain[k0 + 4 * i + kr];
    }
#pragma unroll
    for (int i = 0; i < 16; ++i) { LAS float* d = scr + (4 * i + kr) * 65 + 4 * nq; d[0] = v[i].x; d[1] = v[i].y; d[2] = v[i].z; d[3] = v[i].w; }
    LGKM_WAIT(); asm volatile("" ::: "memory");
    const int c = lane & 7, nr = lane >> 3;
#pragma unroll
    for (int j = 0; j < 8; ++j) { const int n = nr + 8 * j; const LAS float* s = scr + (8 * c) * 65 + n;
        u32x4 o; o.x = cvt_pk_bf16(s[0 * 65], s[1 * 65]); o.y = cvt_pk_bf16(s[2 * 65], s[3 * 65]); o.z = cvt_pk_bf16(s[4 * 65], s[5 * 65]); o.w = cvt_pk_bf16(s[6 * 65], s[7 * 65]);
        *(GAS u32x4*)(WT + ((size_t)(((n0 + n) >> 8) * (K >> 6) + (k0 >> 6)) * 256 + ((n0 + n) & 255)) * 64 + 8 * c) = o; }
    LGKM_WAIT(); asm volatile("" ::: "memory");
}

struct MixCtx { const bf16* proj; bf16* mix; const float* state_pool; const float* state_conv; const float* conv_w; const float* conv_b;
                float* npp; float* ncp; float* nps; float* ncs; int layer; };
__device__ __forceinline__ f32x4 ld_bf4(const GAS unsigned char* p) { const u32x2 u = *(const GAS u32x2*)p; return (f32x4){bf_lo(u.x), bf_hi(u.x), bf_lo(u.y), bf_hi(u.y)}; }
__device__ __forceinline__ void st_bf4(GAS unsigned char* p, f32x4 v) { *(GAS u32x2*)p = (u32x2){cvt_pk_bf16(v.x, v.y), cvt_pk_bf16(v.z, v.w)}; }
__device__ __forceinline__ unsigned prow_of(int b, int t) { return (unsigned)((8 * b + (t >> 8)) * PR + (t & 255)); }
__device__ __forceinline__ unsigned pbyte(int b, int t, int col, int KT) { return 2u * ablk(8 * b + (t >> 8), t & 255, col, KT); }

__device__ __forceinline__ void mix_prompt(const MixCtx& M, int pm, int q, int tid) {
    const int b = pm >> 3, layer = M.layer;
    const int role = tid >> 8, rg = (tid >> 7) & 1, c4 = (tid & 127) * 4;
    const int t0 = (pm & 7) * 256 + 64 * q + 32 * rg;
    const GAS unsigned char* pb_ = (const GAS unsigned char*)M.proj; GAS unsigned char* mb_ = (GAS unsigned char*)M.mix;
    if (role == 0) {
        const int W = 2 << (c4 >> 7);
        f32x4 S = {0.f, 0.f, 0.f, 0.f};
#pragma unroll
        for (int j = 1; j < 16; ++j) { const int p = t0 - j; const f32x4 hv_ = ld_bf4(pb_ + pbyte(b, p >= 0 ? p : 0, c4, 32)); if (p >= 0 && j < W) S += hv_; }
        {
            u32x2 ar[32], orr[32];
#pragma unroll
            for (int i = 0; i < 32; ++i) { const int p = t0 + i, po = p - W + 1;
                ar[i] = *(const GAS u32x2*)(pb_ + pbyte(b, p, c4, 32)); orr[i] = *(const GAS u32x2*)(pb_ + pbyte(b, po >= 0 ? po : 0, c4, 32)); }
#pragma unroll
            for (int i = 0; i < 32; ++i) { const int p = t0 + i;
                const f32x4 a = {bf_lo(ar[i].x), bf_hi(ar[i].x), bf_lo(ar[i].y), bf_hi(ar[i].y)}, old = {bf_lo(orr[i].x), bf_hi(orr[i].x), bf_lo(orr[i].y), bf_hi(orr[i].y)};
                S += a;
                const int cnt = (p + 1 < W) ? p + 1 : W;
                st_bf4(mb_ + pbyte(b, p, c4, 16), S * (1.0f / (float)cnt) - a);
                if (p - W + 1 >= 0) S -= old; }
        }
    } else {
        const unsigned co = 2u * (unsigned)c4;
        const f32x4 w0 = *(const GAS f32x4*)(M.conv_w + (size_t)(layer * 3 + 0) * CW + c4), w1 = *(const GAS f32x4*)(M.conv_w + (size_t)(layer * 3 + 1) * CW + c4),
                    w2 = *(const GAS f32x4*)(M.conv_w + (size_t)(layer * 3 + 2) * CW + c4), bias = *(const GAS f32x4*)(M.conv_b + (size_t)layer * CW + c4);
        f32x4 cm2 = {0.f, 0.f, 0.f, 0.f}, cm1 = {0.f, 0.f, 0.f, 0.f};
        if (t0 >= 2) { cm2 = ld_bf4(pb_ + pbyte(b, t0 - 2, 1024 + c4, 32)) * ld_bf4(pb_ + pbyte(b, t0 - 2, 1536 + c4, 32));
                       cm1 = ld_bf4(pb_ + pbyte(b, t0 - 1, 1024 + c4, 32)) * ld_bf4(pb_ + pbyte(b, t0 - 1, 1536 + c4, 32)); }
        {
            u32x2 bgr[32], cgr[32], vr[32];
#pragma unroll
            for (int i = 0; i < 32; ++i) { const int p = t0 + i; bgr[i] = *(const GAS u32x2*)(pb_ + pbyte(b, p, 512 + c4, 32)); cgr[i] = *(const GAS u32x2*)(pb_ + pbyte(b, p, 1024 + c4, 32)); vr[i] = *(const GAS u32x2*)(pb_ + pbyte(b, p, 1536 + c4, 32)); }
#pragma unroll
            for (int i = 0; i < 32; ++i) {
                const f32x4 bg = {bf_lo(bgr[i].x), bf_hi(bgr[i].x), bf_lo(bgr[i].y), bf_hi(bgr[i].y)};
                const f32x4 cc = (f32x4){bf_lo(cgr[i].x), bf_hi(cgr[i].x), bf_lo(cgr[i].y), bf_hi(cgr[i].y)} * (f32x4){bf_lo(vr[i].x), bf_hi(vr[i].x), bf_lo(vr[i].y), bf_hi(vr[i].y)};
                const f32x4 z = bias + w0 * cm2 + w1 * cm1 + w2 * cc;
                st_bf4(mb_ + pbyte(b, t0 + i, 512 + c4, 16), bg * z);
                cm2 = cm1; cm1 = cc; }
        }
    }
    if ((pm & 7) == 7 && q == 3) {
        if (tid < 128) {
#pragma unroll 1
            for (int i = 0; i < 15; ++i) *(GAS f32x4*)(M.npp + ((size_t)(layer * NB + b) * 15 + i) * PW + c4) = ld_bf4(pb_ + pbyte(b, SEQ - 15 + i, c4, 32));
        } else if (tid >= 256 && tid < 384) {
#pragma unroll 1
            for (int i = 0; i < 2; ++i)
                *(GAS f32x4*)(M.ncp + ((size_t)(layer * NB + b) * 2 + i) * CW + c4) = ld_bf4(pb_ + pbyte(b, SEQ - 2 + i, 1024 + c4, 32)) * ld_bf4(pb_ + pbyte(b, SEQ - 2 + i, 1536 + c4, 32));
        }
    }
}
__device__ __forceinline__ void mix_sample(const MixCtx& M, int pm, int q, int tid) {
    const int sb = 2 * pm + q, layer = M.layer, c4 = (tid & 127) * 4, L0 = 256 + 8 * q;
    const GAS unsigned char* pb_ = (const GAS unsigned char*)M.proj; GAS unsigned char* mb_ = (GAS unsigned char*)M.mix;
    if (tid < 128) {
        const int W = 2 << (c4 >> 7);
        const float* sp = M.state_pool + (size_t)(layer * DB + sb) * 15 * PW + c4;
        float* nps = M.nps + (size_t)(layer * DB + sb) * 15 * PW + c4;
        f32x4 S = {0.f, 0.f, 0.f, 0.f};
#pragma unroll 1
        for (int j = 1; j < W; ++j) S += *(const GAS f32x4*)(sp + (size_t)(15 - j) * PW);
#pragma unroll 1
        for (int r = 0; r < 8; ++r) {
            const f32x4 a = ld_bf4(pb_ + 2u * ablk(pm, L0 + r, c4, 32));
            const int po = r - W + 1;
            f32x4 old; if (po >= 0) old = ld_bf4(pb_ + 2u * ablk(pm, L0 + po, c4, 32)); else old = *(const GAS f32x4*)(sp + (size_t)(15 + po) * PW);
            S += a;
            st_bf4(mb_ + 2u * ablk(pm, L0 + r, c4, 16), S * (1.0f / (float)W) - a);
            *(GAS f32x4*)(nps + (size_t)(7 + r) * PW) = a;
            S -= old; }
#pragma unroll 1
        for (int i = 0; i < 7; ++i) *(GAS f32x4*)(nps + (size_t)i * PW) = *(const GAS f32x4*)(sp + (size_t)(8 + i) * PW);
    } else if (tid >= 256 && tid < 384) {
        const float* sc = M.state_conv + (size_t)(layer * DB + sb) * 2 * CW + c4;
        const f32x4 w0 = *(const GAS f32x4*)(M.conv_w + (size_t)(layer * 3 + 0) * CW + c4), w1 = *(const GAS f32x4*)(M.conv_w + (size_t)(layer * 3 + 1) * CW + c4),
                    w2 = *(const GAS f32x4*)(M.conv_w + (size_t)(layer * 3 + 2) * CW + c4), bias = *(const GAS f32x4*)(M.conv_b + (size_t)layer * CW + c4);
        f32x4 cm2 = *(const GAS f32x4*)sc, cm1 = *(const GAS f32x4*)(sc + CW);
#pragma unroll 1
        for (int r = 0; r < 8; ++r) {
            const f32x4 bg = ld_bf4(pb_ + 2u * ablk(pm, L0 + r, 512 + c4, 32)), cc = ld_bf4(pb_ + 2u * ablk(pm, L0 + r, 1024 + c4, 32)) * ld_bf4(pb_ + 2u * ablk(pm, L0 + r, 1536 + c4, 32));
            const f32x4 z = bias + w0 * cm2 + w1 * cm1 + w2 * cc;
            st_bf4(mb_ + 2u * ablk(pm, L0 + r, 512 + c4, 16), bg * z);
            if (r >= 6) *(GAS f32x4*)(M.ncs + ((size_t)(layer * DB + sb) * 2 + (r - 6)) * CW + c4) = cc;
            cm2 = cm1; cm1 = cc; }
    }
}

__global__ void __launch_bounds__(512) fwd_kernel(Args args) {
    extern __shared__ __attribute__((aligned(16))) unsigned char lds_raw[];
    LAS unsigned char* lds = (LAS unsigned char*)lds_raw;
    const int tid = threadIdx.x, lane = tid & 63, wave = __builtin_amdgcn_readfirstlane(tid >> 6);
    const int G = gridDim.x, bx = blockIdx.x, vcu = (G % 8 == 0) ? (bx % 8) * (G / 8) + bx / 8 : bx;
    const int pm_ = vcu >> 2, q_ = vcu & 3;
    unsigned char* ws = args.ws;
    const int lo = args.ph_lo, hi = args.ph_hi;

    volatile LAS unsigned* MISC = (volatile LAS unsigned*)(lds + MISC_OFF);
    if (tid < 64) MISC[tid] = 0u;
    __syncthreads();
    XcdBarrier bar; bar.bar = (unsigned*)(ws + WS_CTL); bar.x = 0; bar.st = MISC;
    if (hi - lo > 1) bar = xcd_barrier_post((unsigned*)(ws + WS_CTL), MISC);
#ifndef PH_EN
#define PH_EN 0x7fff
#endif
#define LY_EN(i) ((PH_EN >> (2 + (i))) & 1)
#define IN(k) (lo <= (k) && (k) < hi)
#define SEAM(k) do { if (IN(k) && IN((k) + 1)) xcd_barrier(bar); } while (0)

    const float* x_prompt = args.in[0]; const float* x_sample = args.in[1]; const float* state_pool = args.in[2]; const float* state_conv = args.in[3];
    const float* p_prompt = args.in[4]; const float* p_sample = args.in[5]; const float* norm_mix = args.in[6]; const float* w_in = args.in[7];
    const float* pool_w = args.in[8]; const float* pool_scale = args.in[9]; const float* conv_w = args.in[10]; const float* conv_b = args.in[11];
    const float* w_out = args.in[12]; const float* norm_mlp = args.in[13]; const float* w_up = args.in[14]; const float* w_down = args.in[15];
    const float* norm_ple = args.in[16]; const float* w_ple_gate = args.in[17]; const float* w_ple_proj = args.in[18]; const float* norm_f = args.in[19];
    float* out = args.out;
    float* ssq0 = (float*)(ws + WS_SSQ0); float* ssq1 = (float*)(ws + WS_SSQ1);
    float* fold = (float*)(ws + WS_FOLD);
    bf16* hA = (bf16*)(ws + WS_HA); bf16* hB = (bf16*)(ws + WS_R + R_HB);
    bf16* pb = (bf16*)(ws + WS_PB);
    bf16* proj = (bf16*)(ws + WS_R + R_PROJ); bf16* mixA = (bf16*)(ws + WS_R + R_MIX); bf16* fbuf = (bf16*)(ws + WS_R + R_F);
    float* stash = (float*)(ws + WS_R + R_STASH) + (size_t)bx * (PR * 256);
    const int gw = vcu * 8 + wave, NGW = G * 8;
    unsigned long long stall = 0;

#if PROBE_STORE
    { unsigned char* dst = ws + WS_R;
      const int fr_ = lane & 15, fq_ = lane >> 4, wr_ = wave >> 2, wc_ = wave & 3;
      const u32x4 val = {(unsigned)tid, 1u, 2u, 3u};
      for (int rnd = 0; rnd < 8; ++rnd) {
        for (int m = 0; m < 8; ++m) {
          const unsigned row = (unsigned)(pm_ * PR + 128 * wr_ + 16 * m), colb = (unsigned)((4 * q_ + (rnd & 3)) * 512 + 128 * wc_);
          if (PROBE_STORE == 2) { const unsigned r0 = row + (lane >> 3), cb_ = colb + 16 * (lane & 7);
            *(GAS u32x4*)(dst + (size_t)r0 * 8192 + cb_) = val; *(GAS u32x4*)(dst + (size_t)(r0 + 8) * 8192 + cb_) = val; }
          else if (PROBE_STORE == 3) { GAS u32x4* p_ = (GAS u32x4*)(dst + (size_t)(row + fr_) * 8192 + colb + 32 * fq_); __builtin_nontemporal_store(val, p_); __builtin_nontemporal_store(val, p_ + 1); }
          else { GAS u32x4* p_ = (GAS u32x4*)(dst + (size_t)(row + fr_) * 8192 + colb + 32 * fq_); p_[0] = val; p_[1] = val; }
        }
        asm volatile("s_waitcnt vmcnt(0)" ::: "memory"); __syncthreads();
      } }
#endif
#if PROBE_MFMAONLY
    if (PROBE_MFMAONLY == 1 || wave < 4) { f32x4 d_[8]; bf16x8 a_, b_;
#pragma unroll
      for (int i = 0; i < 8; ++i) d_[i] = (f32x4){0.f, 0.f, 0.f, 0.f};
#pragma unroll
      for (int i = 0; i < 8; ++i) { a_[i] = (short)(tid + i); b_[i] = (short)(lane * 3 + i); }
#pragma unroll 1
      for (int it = 0; it < 64 * 68 / 8; ++it) {
#pragma unroll
          for (int i = 0; i < 8; ++i) d_[i] = __builtin_amdgcn_mfma_f32_16x16x32_bf16(a_, b_, d_[i], 0, 0, 0);
      }
      asm volatile("" :: "v"(d_[0]), "v"(d_[1]), "v"(d_[2]), "v"(d_[3]), "v"(d_[4]), "v"(d_[5]), "v"(d_[6]), "v"(d_[7])); }
    __syncthreads();
#endif
    for (int rep = 0; rep < 1 + (PROBE_PH == 6 ? PROBE_REPS : 0); ++rep) {
    if (rep) xcd_barrier(bar);
    if ((PH_EN & 1) && IN(0)) {
        for (int R = 4 * gw; R < MT; R += 4 * NGW) {
            f32x4 v[4][4];
#pragma unroll
            for (int r = 0; r < 4; ++r) { const GAS f32x4* xr = (const GAS f32x4*)x_row(x_prompt, x_sample, R + r) + lane;
#pragma unroll
                for (int j = 0; j < 4; ++j) v[r][j] = xr[64 * j]; }
#pragma unroll
            for (int r = 0; r < 4; ++r) { float s = 0.f;
#pragma unroll
                for (int j = 0; j < 4; ++j) s += (v[r][j].x * v[r][j].x + v[r][j].y * v[r][j].y) + (v[r][j].z * v[r][j].z + v[r][j].w * v[r][j].w);
                s = wave_sum(s);
                const int pmr = (R + r) / PR, lrr = (R + r) - pmr * PR;
#pragma unroll
                for (int j = 0; j < 4; ++j) *(GAS u32x2*)(hA + ablk(pmr, lrr, 4 * (lane + 64 * j), 16)) = (u32x2){cvt_pk_bf16(v[r][j].x, v[r][j].y), cvt_pk_bf16(v[r][j].z, v[r][j].w)};
                if (lane < NSLOT) ssq0[(size_t)(R + r) * NSLOT + lane] = (lane == 0) ? s : 0.f; }
        }
        for (int i0 = 8 * gw; i0 < 2 * MT; i0 += 8 * NGW) {
            f32x4 v[8];
#pragma unroll
            for (int r = 0; r < 8; ++r) { const int idx = i0 + r; const int l = idx / MT, R = idx - l * MT, pmr = R / PR, i = R - pmr * PR;
                const float* sp = i < 256 ? p_prompt + ((size_t)l * MP + 256 * pmr + i) * PLE : p_sample + ((size_t)l * MS + 16 * pmr + i - 256) * PLE;
                v[r] = ((const GAS f32x4*)sp)[lane]; }
#pragma unroll
            for (int r = 0; r < 8; ++r) { const int idx = i0 + r; const int l = idx / MT, R = idx - l * MT, pmr = R / PR, lrr = R - pmr * PR;
                *(GAS u32x2*)(pb + (size_t)l * MT * PLE + ablk(pmr, lrr, 4 * lane, 4)) = (u32x2){cvt_pk_bf16(v[r].x, v[r].y), cvt_pk_bf16(v[r].z, v[r].w)}; }
        }
        {
            LAS float* scr = (LAS float*)(lds + wave * 16640);
            constexpr int I_IN = 16 * 32, I_OUT = 8 * 16, I_UP = 16 * 64, I_DN = 64 * 16, I_G = 16 * 16, I_P = 4 * 16, I_L = I_IN + I_OUT + I_UP + I_DN + I_G + I_P;
            for (int it = gw; it < DEPTH * I_L; it += NGW) {
                const int l = it / I_L; int r = it - l * I_L; unsigned char* wl = ws + WS_W + (size_t)l * W_LAYER;
                if (r < I_IN) { const int kb = r / 32, nb = r % 32; transpose64(w_in + (size_t)l * D * INC, INC, norm_mix + l * D, (bf16*)(wl + W_IN), D, 64 * kb, 64 * nb, scr, lane); continue; } r -= I_IN;
                if (r < I_OUT) { const int kb = 8 + r / 16, nb = r % 16; transpose64(w_out + (size_t)l * D * D, D, nullptr, (bf16*)(wl + W_OUT), D, 64 * kb, 64 * nb, scr, lane); continue; } r -= I_OUT;
                if (r < I_UP) { const int kb = r / 64, nb = r % 64; transpose64(w_up + (size_t)l * D * DFF, DFF, norm_mlp + l * D, (bf16*)(wl + W_UP), D, 64 * kb, 64 * nb, scr, lane); continue; } r -= I_UP;
                if (r < I_DN) { const int kb = r / 16, nb = r % 16; transpose64(w_down + (size_t)l * DFF * D, D, nullptr, (bf16*)(wl + W_DN), DFF, 64 * kb, 64 * nb, scr, lane); continue; } r -= I_DN;
                if (r < I_G) { const int kb = r / 16, nb = r % 16; transpose64(w_ple_gate + (size_t)l * D * D, D, norm_ple + l * D, (bf16*)(wl + W_G), D, 64 * kb, 64 * nb, scr, lane); continue; } r -= I_G;
                { const int kb = r / 16, nb = r % 16; transpose64(w_ple_proj + (size_t)l * PLE * D, D, nullptr, (bf16*)(wl + W_P), PLE, 64 * kb, 64 * nb, scr, lane); }
            }
        }
        for (int it = gw; it < DEPTH * 4 * 64 * 4; it += NGW) {
            const int nb = it & 3, k2 = (it >> 2) & 63, g = (it >> 8) & 3, l = it >> 10;
            const float* pw0 = pool_w + ((size_t)(l * 4 + g) * 128 + 2 * k2) * 128; const float* sc = pool_scale + l * PW + 128 * g;
            const GAS f32x4* wo = (const GAS f32x4*)(w_out + ((size_t)l * D + 128 * g) * D + 256 * nb) + lane;
            f32x4 a0 = {0.f, 0.f, 0.f, 0.f}, a1 = {0.f, 0.f, 0.f, 0.f};
#pragma unroll 8
            for (int c = 0; c < 128; ++c) { const f32x4 w = wo[(size_t)c * (D / 4)] * sc[c]; a0 += w * pw0[c]; a1 += w * pw0[128 + c]; }
            GAS f32x4* fo = (GAS f32x4*)(fold + ((size_t)l * 512 + 128 * g + 2 * k2) * D + 256 * nb) + lane;
            fo[0] = a0; fo[D / 4] = a1;
        }
        __syncthreads();
    } }
    SEAM(1);
    if (PROBE_PH == 8) for (int rep = 0; rep < PROBE_REPS; ++rep) xcd_barrier(bar);

    if ((PH_EN & 2) && IN(2)) {
        if (wave == 7) { int vc = vcu; LAUNDER_S(vc); const int ly = vc >> 7, r = vc & 127, kb = r >> 4, nb = r & 15;
            transpose64((const float*)(ws + WS_FOLD) + (size_t)ly * 512 * D, D, nullptr, (bf16*)(ws + WS_W + (size_t)ly * W_LAYER + W_OUT), D, 64 * kb, 64 * nb, (LAS float*)(lds + RSTD_OFF + 1280), lane); }
    }
#pragma unroll 1
    for (int l = 0; l < DEPTH; ++l) {
        const int p0 = 2 + 6 * l;
        int pm = pm_; int q = q_;
        const unsigned char* wl = ws + WS_W + (size_t)l * W_LAYER;
        const bf16* hin = (l == 0) ? hA : hB;
        float* ssA = (l == 0) ? ssq0 : ssq1;
        float* ssB = (l == 0) ? ssq1 : ssq0;
        for (int rep = 0; rep < 1 + (PROBE_PH == 0 ? PROBE_REPS : 0); ++rep) {
        if (rep) xcd_barrier(bar);
        if (LY_EN(0) && IN(p0 + 0)) { LAUNDER_S(pm); LAUNDER_S(q);
            SrcPlain S{(const unsigned char*)(hin + (size_t)pm * PR * D), wl + W_IN, 16, 2 * q, 2, ((pm & 7) + 2 * q) & 7};
            panel_rstd(lds, ssA, pm, tid);
            PostScale<0> P{lds, proj, INC, pm, 2 * q, 16, 0, 0};
            gemm_stream(lds, S, P, 32, wave, lane, stall);
        } }
        SEAM(p0 + 0);
        for (int rep = 0; rep < 1 + (PROBE_PH == 1 ? PROBE_REPS : 0); ++rep) {
        if (rep) xcd_barrier(bar);
        if (LY_EN(1) && IN(p0 + 1)) { LAUNDER_S(pm); LAUNDER_S(q);
            MixCtx M{proj, mixA, state_pool, state_conv, conv_w, conv_b, out + O_NPP, out + O_NCP, out + O_NPS, out + O_NCS, l};
            int tidm = tid; LAUNDER_V(tidm);
            mix_prompt(M, pm, q, tidm);
            if (q < 2) mix_sample(M, pm, q, tidm);
        } }
        SEAM(p0 + 1);
        for (int rep = (PROBE_PH == 2 ? PROBE_REPS : 0); rep >= 0; --rep) {
        if (LY_EN(2) && IN(p0 + 2)) { LAUNDER_S(pm); LAUNDER_S(q);
            SrcPlain S{(const unsigned char*)(mixA + (size_t)pm * PR * D), wl + W_OUT, 16, q, 1, ((pm & 7) + 2 * q) & 7};
            PostRes P{hin, rep ? (bf16*)out : hA, rep ? (float*)out + 9000000 : ssB, pm, q, 16, 0};
            gemm_stream(lds, S, P, 16, wave, lane, stall);
        }
        if (rep) xcd_barrier(bar); }
        SEAM(p0 + 2);
        for (int rep = 0; rep < 1 + (PROBE_PH == 3 ? PROBE_REPS : 0); ++rep) {
        if (rep) xcd_barrier(bar);
        if (LY_EN(3) && IN(p0 + 3)) { LAUNDER_S(pm); LAUNDER_S(q);
            SrcPlain S{(const unsigned char*)(hA + (size_t)pm * PR * D), wl + W_UP, 16, 4 * q, 4, ((pm & 7) + 2 * q) & 7};
            panel_rstd(lds, ssB, pm, tid);
            PostScale<1> P{lds, fbuf, DFF, pm, 4 * q, 16, 0, 0};
            if (rep == 0) gemm_stream(lds, S, P, 64, wave, lane, stall); else gemm_stream<(PROBE_DRY == 5) ? 0 : PROBE_DRY>(lds, S, P, 64, wave, lane, stall);
        } }
        SEAM(p0 + 3);
        for (int rep = (PROBE_PH == 4 ? PROBE_REPS : 0); rep >= 0; --rep) {
        if (LY_EN(4) && IN(p0 + 4)) { LAUNDER_S(pm); LAUNDER_S(q);
            SrcPlain S{(const unsigned char*)(fbuf + (size_t)pm * PR * DFF), wl + W_DN, 64, q, 1, ((pm & 7) + 2 * q) & 7};
            PostRes P{hA, rep ? (bf16*)out : hA, rep ? (float*)out + 9000000 : ssA, pm, q, 64, 0};
            gemm_stream(lds, S, P, 64, wave, lane, stall);
        }
        if (rep) xcd_barrier(bar); }
        SEAM(p0 + 4);
        for (int rep = 0; rep < 1 + (PROBE_PH == 5 ? PROBE_REPS : 0); ++rep) {
        if (rep) xcd_barrier(bar);
        if (LY_EN(5) && IN(p0 + 5)) { LAUNDER_S(pm); LAUNDER_S(q);
            SrcPle S{(const unsigned char*)(pb + ((size_t)l * MT + (size_t)pm * PR) * PLE), wl + W_P + (size_t)q * 4 * BBLK,
                     (const unsigned char*)(hA + (size_t)pm * PR * D), wl + W_G + (size_t)q * 16 * BBLK, ((pm & 7) + 2 * q) & 7};
            panel_rstd(lds, ssA, pm, tid);
            PostPle P{lds, hA, hB, ssB, stash, pm, q};
            gemm_stream(lds, S, P, 20, wave, lane, stall);
        } }
        SEAM(p0 + 5);
    }
    for (int rep = 0; rep < 1 + (PROBE_PH == 7 ? PROBE_REPS : 0); ++rep) {
    if (rep) xcd_barrier(bar);
    if ((PH_EN & 0x4000) && IN(14)) {
        f32x4 gv[4];
#pragma unroll
        for (int j = 0; j < 4; ++j) gv[j] = ((const GAS f32x4*)norm_f)[lane * 2 + (j & 1) + 128 * (j >> 1)];
        {
            u32x4 ha[9], hbq[9];
#pragma unroll
            for (int k = 0; k < 9; ++k) { int R = gw + k * NGW; R = R < MT ? R : MT - 1; const int pmr = R / PR, i = R - pmr * PR;
                ha[k] = *(const GAS u32x4*)(hB + ablk(pmr, i, 8 * lane, 16)); hbq[k] = *(const GAS u32x4*)(hB + ablk(pmr, i, 512 + 8 * lane, 16)); }
#pragma unroll
            for (int k = 0; k < 9; ++k) { const int R = gw + k * NGW;
                const u32x4 a = ha[k], b = hbq[k];
                float v[16] = {bf_lo(a.x), bf_hi(a.x), bf_lo(a.y), bf_hi(a.y), bf_lo(a.z), bf_hi(a.z), bf_lo(a.w), bf_hi(a.w),
                               bf_lo(b.x), bf_hi(b.x), bf_lo(b.y), bf_hi(b.y), bf_lo(b.z), bf_hi(b.z), bf_lo(b.w), bf_hi(b.w)};
                float s = 0.f;
#pragma unroll
                for (int kk = 0; kk < 16; ++kk) s += v[kk] * v[kk];
                s = wave_sum(s);
                const float rs = __builtin_amdgcn_rsqf(s * (1.0f / D) + EPS);
                if (R < MT) { const int pmr = R / PR, i = R - pmr * PR;
                    float* dst = i < 256 ? out + O_YP + (size_t)(256 * pmr + i) * D : out + O_YS + (size_t)(16 * pmr + i - 256) * D;
                    GAS f32x4* o = (GAS f32x4*)dst;
                    o[lane * 2 + 0] = (f32x4){v[0] * rs * gv[0].x, v[1] * rs * gv[0].y, v[2] * rs * gv[0].z, v[3] * rs * gv[0].w};
                    o[lane * 2 + 1] = (f32x4){v[4] * rs * gv[1].x, v[5] * rs * gv[1].y, v[6] * rs * gv[1].z, v[7] * rs * gv[1].w};
                    o[128 + lane * 2 + 0] = (f32x4){v[8] * rs * gv[2].x, v[9] * rs * gv[2].y, v[10] * rs * gv[2].z, v[11] * rs * gv[2].w};
                    o[128 + lane * 2 + 1] = (f32x4){v[12] * rs * gv[3].x, v[13] * rs * gv[3].y, v[14] * rs * gv[3].z, v[15] * rs * gv[3].w}; }
            }
        }
    } }
#if PROBE_XCC
    { unsigned* xw = (unsigned*)(ws + WS_CTL + 40960);
      if (tid == 0) { const unsigned me = xb_xcc_id() + 1u; const unsigned old_ = atomicCAS(xw + (bx & 7), 0u, me); if (old_ != 0u && old_ != me) atomicAdd(xw + 8, 1u); }
      xcd_barrier(bar);
      if (bx == 0 && wave == 0) { const unsigned bad = __hip_atomic_load(xw + 8, __ATOMIC_RELAXED, __HIP_MEMORY_SCOPE_AGENT);
        if (bad) { const unsigned long long t0_ = rstamp(); while (rstamp() - t0_ < 40000ull) __builtin_amdgcn_s_sleep(8); } } }
#endif
#if PROBE_STALL >= 11
    if (bx == 0 && wave == ((PROBE_STALL == 12) ? 4 : 0)) { const unsigned long long t0_ = rstamp(); while (rstamp() - t0_ < stall) __builtin_amdgcn_s_sleep(8); }
#elif PROBE_STALL >= 9
    if (bx == 0 && wave == 0) { const unsigned long long tgt = (PROBE_STALL == 9) ? stall : stall / 24; const unsigned long long t0_ = rstamp(); while (rstamp() - t0_ < tgt) __builtin_amdgcn_s_sleep(8); }
#elif PROBE_STALL >= 6 && PROBE_STALL <= 8
    { unsigned long long* red = (unsigned long long*)(ws + WS_CTL + 32768);
      if (lane == 0 && wave == ((PROBE_STALL == 8) ? 4 : 0)) { if (PROBE_STALL == 7) atomicMax(red, ~stall); else atomicMax(red, stall); }
      xcd_barrier(bar);
      if (bx == 0 && wave == 0) { unsigned long long tgt = __hip_atomic_load(red, __ATOMIC_RELAXED, __HIP_MEMORY_SCOPE_AGENT); if (PROBE_STALL == 7) tgt = ~tgt;
        const unsigned long long t0_ = tstamp(); while (tstamp() - t0_ < tgt) __builtin_amdgcn_s_sleep(8); } }
#elif PROBE_STALL
    if (bx == 0 && wave == 0) { const unsigned long long t0_ = tstamp(); while (tstamp() - t0_ < stall) __builtin_amdgcn_s_sleep(8); }
#endif
#undef IN
#undef SEAM
}

extern "C" void kernel_launch(void* const* d_in, const int* in_sizes, int n_in, void* d_out, int out_size, void* d_ws, size_t ws_size, hipStream_t stream) {
    static int ready = 0;
    if (ready == 0) {
        if (n_in != 20 || out_size != (int)O_END || ws_size < WS_END) { fprintf(stderr, "kernel_launch: unexpected shapes (n_in %d out %d ws %zu)\n", n_in, out_size, ws_size); ready = -1; return; }
        if (hipFuncSetAttribute((const void*)fwd_kernel, hipFuncAttributeMaxDynamicSharedMemorySize, LDS_BYTES) != hipSuccess) { fprintf(stderr, "kernel_launch: hipFuncSetAttribute failed\n"); ready = -1; return; }
        ready = 1;
    }
    if (ready < 0) return;
    (void)in_sizes;
    (void)hipMemsetAsync((char*)d_ws + WS_CTL, 0, CTL_BYTES, stream);
    Args a{};
    for (int i = 0; i < 20; ++i) a.in[i] = (const float*)d_in[i];
    a.out = (float*)d_out; a.ws = (unsigned char*)d_ws;
#if N_LAUNCH_MODE == 1
    a.ph_lo = 0; a.ph_hi = NPHASE;
    hipLaunchKernelGGL(fwd_kernel, dim3(256), dim3(512), LDS_BYTES, stream, a);
#else
    for (int p = 0; p < NPHASE; ++p) { a.ph_lo = p; a.ph_hi = p + 1; hipLaunchKernelGGL(fwd_kernel, dim3(256), dim3(512), LDS_BYTES, stream, a); }
#endif
}
```

```cpp
#include <hip/hip_runtime.h>
#include <cstdio>
#include <cstdint>

#ifndef PROBE_PH
#define PROBE_PH -1
#endif
#ifndef PROBE_MFMA2
#define PROBE_MFMA2 0
#endif
#ifndef PROBE_LOAD2
#define PROBE_LOAD2 0
#endif
#ifndef PROBE_STALL
#define PROBE_STALL 0
#endif
#ifndef PROBE_LDS2
#define PROBE_LDS2 0
#endif
#ifndef PROBE_MFMAONLY
#define PROBE_MFMAONLY 0
#endif
#ifndef PROBE_XCC
#define PROBE_XCC 0
#endif
#ifndef PROBE_DRY
#define PROBE_DRY 0
#endif
#ifndef PROBE_STORE
#define PROBE_STORE 0
#endif
#ifndef PROBE_EPI
#define PROBE_EPI 0
#endif
#ifndef SKEW_UNITS
#define SKEW_UNITS 0
#endif
#ifndef NT_WEIGHTS
#define NT_WEIGHTS 0
#endif
#ifndef PROBE_REPS
#define PROBE_REPS 0
#endif
#ifndef N_LAUNCH_MODE
#define N_LAUNCH_MODE 1
#endif

#define LAS __attribute__((address_space(3)))
#define GAS __attribute__((address_space(1)))
typedef unsigned short bf16;
typedef short bf16x8 __attribute__((ext_vector_type(8)));
typedef float f32x4 __attribute__((ext_vector_type(4)));
typedef float f32x2 __attribute__((ext_vector_type(2)));
typedef unsigned u32x4 __attribute__((ext_vector_type(4)));
typedef unsigned u32x2 __attribute__((ext_vector_type(2)));

constexpr int D = 1024, SEQ = 2048, NB = 8, DB = 128, DS = 8, DEPTH = 2, PW = 512, CW = 512, DFF = 4096, PLE = 256, INC = 2048;
constexpr int MP = NB * SEQ, MS = DB * DS, MT = MP + MS;
constexpr int NPAN = 64, PR = 272;
constexpr float EPS = 1e-6f;
constexpr int NPHASE = 15;

constexpr size_t O_YP = 0, O_YS = O_YP + (size_t)MP * D, O_NPP = O_YS + (size_t)MS * D, O_NCP = O_NPP + (size_t)DEPTH * NB * 15 * PW,
                 O_NPS = O_NCP + (size_t)DEPTH * NB * 2 * CW, O_NCS = O_NPS + (size_t)DEPTH * DB * 15 * PW, O_END = O_NCS + (size_t)DEPTH * DB * 2 * CW;

constexpr size_t MiB = 1u << 20;
constexpr size_t WS_CTL = 0, CTL_BYTES = 64 * 1024;
constexpr int NSLOT = 32;
constexpr size_t WS_SSQ0 = 1 * MiB, SSQ_BYTES = (size_t)MT * NSLOT * 4;
constexpr size_t WS_SSQ1 = WS_SSQ0 + 2 * MiB + 256 * 1024;
constexpr size_t WS_FOLD = 6 * MiB;
constexpr size_t WS_W = 10 * MiB;
constexpr size_t W_IN = 0, W_OUT = 4 * MiB, W_UP = 6 * MiB, W_DN = 14 * MiB, W_G = 22 * MiB, W_P = 24 * MiB, W_LAYER = 24 * MiB + 512 * 1024;
constexpr size_t WS_HA = WS_W + 2 * W_LAYER;
constexpr size_t WS_PB = WS_HA + 34 * MiB;
constexpr size_t WS_R = WS_PB + 17 * MiB;
constexpr size_t R_PROJ = 0, R_MIX = 68 * MiB, R_HB = 102 * MiB, R_F = 0, R_STASH = 0;
constexpr size_t WS_END = WS_R + 136 * MiB;
static_assert(WS_END <= 256 * MiB, "ws map");
static_assert((size_t)MT * D * 2 == 34 * MiB && (size_t)MT * DFF * 2 == 136 * MiB && (size_t)MT * INC * 2 == 68 * MiB, "sizes");

constexpr int SUBT = 1024;
constexpr int A_SUBS = 17, B_SUBS = 16, STAGE_BYTES = (A_SUBS + B_SUBS) * SUBT;
constexpr int NSLOTS = 4;
constexpr int MISC_OFF = NSLOTS * STAGE_BYTES;
constexpr int RSTD_OFF = MISC_OFF + 1024;
constexpr int LDS_BYTES = RSTD_OFF + 1280 + 16640;

#define VM_WAIT() asm volatile("s_waitcnt vmcnt(0)" ::: "memory")
#define LGKM_WAIT() asm volatile("s_waitcnt lgkmcnt(0)" ::: "memory")
#define LAUNDER_V(x_) asm volatile("" : "+v"(x_))
#define LAUNDER_S(x_) asm volatile("" : "+s"(x_))
__device__ __forceinline__ unsigned long long tstamp() { unsigned long long t; asm volatile("s_memtime %0\n\ts_waitcnt lgkmcnt(0)" : "=s"(t) :: "memory"); return t; }
__device__ __forceinline__ unsigned long long rstamp() { unsigned long long t; asm volatile("s_memrealtime %0\n\ts_waitcnt lgkmcnt(0)" : "=s"(t) :: "memory"); return t; }
#define BAR() do { asm volatile("" ::: "memory"); __builtin_amdgcn_s_barrier(); asm volatile("" ::: "memory"); } while (0)
__device__ __forceinline__ unsigned cvt_pk_bf16(float lo, float hi) { unsigned r; asm volatile("v_cvt_pk_bf16_f32 %0, %1, %2" : "=v"(r) : "v"(lo), "v"(hi)); return r; }
__device__ __forceinline__ float bf_lo(unsigned u) { return __builtin_bit_cast(float, u << 16); }
__device__ __forceinline__ float bf_hi(unsigned u) { return __builtin_bit_cast(float, u & 0xffff0000u); }
__device__ __forceinline__ float wave_sum(float v) {
#pragma unroll
    for (int o = 1; o < 64; o <<= 1) v += __shfl_xor(v, o);
    return v;
}

#define XB_TMO      128
#define XB_XCNT(j)  (256  + 64 * (j))
#define XB_XSUB(j)  (1280 + 64 * (j))
#define XB_XGEN(j)  (2304 + 64 * (j))
#define XB_TOP      3328
#define XB_TOPGEN   3392
#define XCD_BAR_WORDS 3456
#define XB_SPIN_CAP (1u << 18)
__device__ __forceinline__ unsigned xb_ld(unsigned* p)              { return __hip_atomic_load(p, __ATOMIC_RELAXED, __HIP_MEMORY_SCOPE_AGENT); }
__device__ __forceinline__ unsigned xb_add(unsigned* p, unsigned v) { return __hip_atomic_fetch_add(p, v, __ATOMIC_RELAXED, __HIP_MEMORY_SCOPE_AGENT); }
__device__ __forceinline__ unsigned xb_xcc_id() { return (unsigned)__builtin_amdgcn_s_getreg((3 << 11) | 20) & 0xFu; }
#define XB_SPIN(cond, bar) do { unsigned _sp = 0; while (cond) { __builtin_amdgcn_s_sleep(1); \
    if ((++_sp & 255u) == 0u) { if (xb_ld(&(bar)[XB_TMO])) break; if (_sp > XB_SPIN_CAP) { atomicAdd(&(bar)[XB_TMO], 1u); break; } } } } while (0)
struct XcdBarrier { unsigned* bar; unsigned x; volatile LAS unsigned* st; };
__device__ __forceinline__ XcdBarrier xcd_barrier_post(unsigned* bar, volatile LAS unsigned* st) {
    XcdBarrier b; b.bar = bar; b.x = xb_xcc_id(); b.st = st;
    if (threadIdx.x == 0) (void)xb_add(&bar[XB_XCNT(b.x)], 1u);
    return b;
}
__device__ __forceinline__ void xcd_barrier_complete(unsigned* bar, unsigned x, unsigned& nloc, unsigned& nx) {
    const unsigned G = gridDim.x * gridDim.y * gridDim.z;
    unsigned sum, cnt, mine, sp = 0u;
    for (;;) {
        sum = 0u; cnt = 0u; mine = 0u;
#pragma unroll
        for (unsigned j = 0; j < 16; ++j) { const unsigned c = xb_ld(&bar[XB_XCNT(j)]); sum += c; cnt += (c > 0u) ? 1u : 0u; mine = (j == x) ? c : mine; }
        if (sum == G) break;
        __builtin_amdgcn_s_sleep(1);
        if ((++sp & 255u) == 0u) { if (xb_ld(&bar[XB_TMO])) break; if (sp > XB_SPIN_CAP) { atomicAdd(&bar[XB_TMO], 1u); break; } }
    }
    nloc = mine > 0u ? mine : 1u; nx = cnt > 0u ? cnt : 1u;
}
__device__ __forceinline__ void xcd_barrier(const XcdBarrier& b) {
    asm volatile("s_waitcnt vmcnt(0)" ::: "memory");
    __syncthreads();
    if (threadIdx.x == 0) {
        unsigned* bar = b.bar;
        __builtin_amdgcn_s_waitcnt(0);
        unsigned nloc = b.st[0], nx = b.st[1];
        if (nloc == 0u) { xcd_barrier_complete(bar, b.x, nloc, nx); b.st[0] = nloc; b.st[1] = nx; }
        const unsigned old = xb_add(&bar[XB_XSUB(b.x)], 1u);
        const unsigned gen = old / nloc;
        if (old + 1u == (gen + 1u) * nloc) {
            __builtin_amdgcn_fence(__ATOMIC_RELEASE, "agent");
            asm volatile("s_waitcnt vmcnt(0)" ::: "memory");
            const unsigned og = xb_add(&bar[XB_TOP], 1u);
            const unsigned tg = og / nx;
            if (og + 1u == (tg + 1u) * nx) xb_add(&bar[XB_TOPGEN], 1u);
            else XB_SPIN(xb_ld(&bar[XB_TOPGEN]) == tg, bar);
            __builtin_amdgcn_fence(__ATOMIC_ACQUIRE, "agent");
            xb_add(&bar[XB_XGEN(b.x)], 1u);
            asm volatile("s_waitcnt vmcnt(0)" ::: "memory");
        } else {
            XB_SPIN(xb_ld(&bar[XB_XGEN(b.x)]) == gen, bar);
            __builtin_amdgcn_fence(__ATOMIC_ACQUIRE, "agent");
            asm volatile("s_waitcnt vmcnt(0)" ::: "memory");
        }
    }
    __syncthreads();
}

struct Args { const float* in[20]; float* out; unsigned char* ws; int ph_lo, ph_hi; };


__device__ __forceinline__ void glds16s(unsigned voff, unsigned long long sbase, unsigned slot, unsigned ldsoff) {
    asm volatile("s_add_u32 m0, %2, %3\n\ts_nop 0\n\tglobal_load_lds_dwordx4 %0, %1" :: "v"(voff), "s"(sbase), "s"(slot), "s"(ldsoff) : "memory", "m0", "scc");
}
__device__ __forceinline__ void glds16s_nt(unsigned voff, unsigned long long sbase, unsigned slot, unsigned ldsoff) {
#if NT_WEIGHTS
    asm volatile("s_add_u32 m0, %2, %3\n\ts_nop 0\n\tglobal_load_lds_dwordx4 %0, %1 nt" :: "v"(voff), "s"(sbase), "s"(slot), "s"(ldsoff) : "memory", "m0", "scc");
#else
    glds16s(voff, sbase, slot, ldsoff);
#endif
}
constexpr unsigned ABLK = PR * 128, BBLK = 256 * 128;
constexpr unsigned ABLK32 = PR * 64, BBLK32 = 256 * 64;
__device__ __forceinline__ unsigned ablk(int pm, int lr, int col, int KT) { return (unsigned)(((pm * 2 * KT + (col >> 5)) * PR + lr) * 32 + (col & 31)); }
__device__ __forceinline__ unsigned eoff(int pm, int KT, int t64, int lr, int fq) { return 2u * (unsigned)(((pm * 2 * KT + 2 * t64 + (fq >> 1)) * PR + lr) * 32 + 16 * (fq & 1)); }
struct Seg { unsigned long long a, b; int nsub; };

#define ISSUE_SUB(slotoff_) do { const unsigned so_ = (unsigned)(unsigned long long)(lds + (slotoff_)); \
    glds16s(voA0, ca, so_, lA0); glds16s(voA1, ca, so_, lA0 + 8 * SUBT); glds16s_nt(voB0, cbp, so_, lB0); glds16s_nt(voB1, cbp, so_, lB0 + 8 * SUBT); \
    if (wave == 0) glds16s(voX, ca, so_, 16 * SUBT); \
    ca += ABLK32; cbp += BBLK32; \
    if (--cleft == 0) { ck = (ck + 1 < S.nseg()) ? ck + 1 : ck; cseg = S.seg(ck); ca = cseg.a; cbp = cseg.b; cleft = cseg.nsub; } } while (0)

#define LDA(slotoff_, m_) (*(const LAS bf16x8*)(lds + (slotoff_) + aoff + (m_) * SUBT + rdoff))
#define LDAX(slotoff_)    (*(const LAS bf16x8*)(lds + (slotoff_) + 16 * SUBT + rdoff))
#define LDB(slotoff_, n_) (*(const LAS bf16x8*)(lds + (slotoff_) + boff + (n_) * SUBT + rdoff))
#define MFMA(a_, b_, c_) c_ = __builtin_amdgcn_mfma_f32_16x16x32_bf16(b_, a_, c_, 0, 0, 0)

struct Acc { f32x4 m[8][4]; f32x4 x[2]; };
__device__ __forceinline__ void zero_acc(Acc& a) {
#pragma unroll
    for (int m = 0; m < 8; ++m)
#pragma unroll
        for (int n = 0; n < 4; ++n) a.m[m][n] = (f32x4){0.f, 0.f, 0.f, 0.f};
    a.x[0] = (f32x4){0.f, 0.f, 0.f, 0.f}; a.x[1] = (f32x4){0.f, 0.f, 0.f, 0.f};
}

#define SB() __builtin_amdgcn_sched_barrier(0)
#define VMCNT_I(n_) asm volatile("s_waitcnt vmcnt(%0)" :: "i"(n_) : "memory")
template <int NST> __device__ __forceinline__ void ring_wait(int& epi_left, int wave) {
    if (epi_left > 0) { --epi_left; if (wave == 0) VMCNT_I(10 + NST); else VMCNT_I(8 + NST); }
    else { if (wave == 0) VMCNT_I(10); else VMCNT_I(8); }
}

template <int DRY = 0, class SRC, class POST>
__device__ __forceinline__ void gemm_stream(LAS unsigned char* lds, const SRC& S, POST& P, const int ntot, const int wave_in, const int lane_in, unsigned long long& stall) {
    int lane = lane_in; LAUNDER_V(lane); int wave = wave_in; LAUNDER_S(wave);
    const int fr = lane & 15, fq = lane >> 4, wr = wave >> 2, wc = wave & 3;
    const unsigned rdoff = (unsigned)((fr * 64 + fq * 16) ^ ((fr >> 3) << 5));
    const int b16 = lane * 16, swz = b16 ^ (((b16 >> 9) & 1) << 5), rr = swz >> 6, cb = swz & 63, pr = 16 * (rr >> 2) + (rr & 3);
    const unsigned aoff = (unsigned)(8 * wr) * SUBT, boff = (unsigned)(A_SUBS + 4 * wc) * SUBT;
    const bool hi = (wr != 0);
    int epi_left = 0;
    Acc acc; zero_acc(acc);
    bf16x8 Bf[4], F[9];
    const int NS = 2 * ntot;
    int ck = 0; Seg cseg = S.seg(0); unsigned long long ca = cseg.a, cbp = cseg.b; int cleft = cseg.nsub;
    const unsigned voA0 = (unsigned)(16 * wave + rr) * 64u + (unsigned)cb, voA1 = voA0 + 128u * 64u, voX = (unsigned)(256 + rr) * 64u + (unsigned)cb;
    const unsigned voB0 = (unsigned)(64 * (wave >> 2) + 4 * (wave & 3) + pr) * 64u + (unsigned)cb, voB1 = voB0 + 128u * 64u;
    const unsigned lA0 = (unsigned)wave * SUBT, lB0 = (unsigned)(A_SUBS + wave) * SUBT;
    if (SKEW_UNITS > 0 && DRY == 0) { const int dly = S.skew(); for (int i = 0; i < dly; ++i) __builtin_amdgcn_s_sleep(SKEW_UNITS); }
    ISSUE_SUB(0); ISSUE_SUB(STAGE_BYTES); ISSUE_SUB(2 * STAGE_BYTES);
    ring_wait<0>(epi_left, wave);
    BAR();
    if (hi) BAR();
#if PROBE_STALL == 9 || PROBE_STALL == 10
    const unsigned long long tl0_ = (PROBE_STALL == 9) ? rstamp() : tstamp();
#elif PROBE_STALL >= 6 && PROBE_STALL <= 8
    const unsigned long long tl0_ = tstamp();
#endif
    bool pend = false;
#pragma unroll 1
    for (int s = 0; s < NS; ++s) {
        const unsigned cs = (unsigned)(s & 3) * STAGE_BYTES, rs = (unsigned)((s + 3) & 3) * STAGE_BYTES;
        SB();
        if (DRY == 0) { if (pend) { P.run(acc, wr, wc, fr, fq); pend = false; epi_left = 2; } }
        if (DRY != 1) {
#pragma unroll
        for (int n = 0; n < 4; ++n) Bf[n] = LDB(cs, n);
#pragma unroll
        for (int m = 0; m < 8; ++m) F[m] = LDA(cs, m);
        F[8] = LDAX(cs);
        }
        SB();
        ISSUE_SUB(rs);
        if (hi) ring_wait<POST::NST>(epi_left, wave);
        LGKM_WAIT();
        BAR();
        if (DRY != 1) {
#pragma unroll
        for (int m = 0; m < 8; ++m)
#pragma unroll
            for (int n = 0; n < 4; ++n) MFMA(F[m], Bf[n], acc.m[m][n]);
        { const bf16x8 bx0 = hi ? Bf[2] : Bf[0], bx1 = hi ? Bf[3] : Bf[1]; MFMA(F[8], bx0, acc.x[0]); MFMA(F[8], bx1, acc.x[1]); }
        }
        if (DRY == 0) { if ((s & 1) && P.due()) { if (hi) { P.run(acc, wr, wc, fr, fq); epi_left = 2; } else pend = true; } }
        if (!hi) ring_wait<POST::NST>(epi_left, wave);
        BAR();
    }
    if (DRY == 0) { if (pend) P.run(acc, wr, wc, fr, fq); }
    if (!hi) BAR();
    LGKM_WAIT(); VM_WAIT(); BAR();
}

__device__ __forceinline__ void panel_rstd(LAS unsigned char* lds, const float* ssq, int pm, int tid) {
    LAS float* rt = (LAS float*)(lds + RSTD_OFF);
    if (tid < PR) {
        const GAS f32x4* p = (const GAS f32x4*)(ssq + (size_t)(pm * PR + tid) * NSLOT);
        float s = 0.f;
#pragma unroll
        for (int i = 0; i < NSLOT / 4; ++i) { const f32x4 q = p[i]; s += (q.x + q.y) + (q.z + q.w); }
        rt[tid] = __builtin_amdgcn_rsqf(s * (1.0f / D) + EPS);
    }
    __syncthreads();
}
#define RSTD(r_) (((const LAS float*)(lds + RSTD_OFF))[r_])
__device__ __forceinline__ void store16(bf16* p, const float (&v)[16]) {
    u32x4 a, b;
    a.x = cvt_pk_bf16(v[0], v[1]); a.y = cvt_pk_bf16(v[2], v[3]); a.z = cvt_pk_bf16(v[4], v[5]); a.w = cvt_pk_bf16(v[6], v[7]);
    b.x = cvt_pk_bf16(v[8], v[9]); b.y = cvt_pk_bf16(v[10], v[11]); b.z = cvt_pk_bf16(v[12], v[13]); b.w = cvt_pk_bf16(v[14], v[15]);
    *(GAS u32x4*)p = a; *(GAS u32x4*)(p + 8) = b;
}
__device__ __forceinline__ void store8(bf16* p, const float (&v)[8]) {
    u32x4 a;
    a.x = cvt_pk_bf16(v[0], v[1]); a.y = cvt_pk_bf16(v[2], v[3]); a.z = cvt_pk_bf16(v[4], v[5]); a.w = cvt_pk_bf16(v[6], v[7]);
    *(GAS u32x4*)p = a;
}
__device__ __forceinline__ void load16(const bf16* p, float (&v)[16]) {
    const u32x4 a = *(const GAS u32x4*)p, b = *(const GAS u32x4*)(p + 8);
    v[0] = bf_lo(a.x); v[1] = bf_hi(a.x); v[2] = bf_lo(a.y); v[3] = bf_hi(a.y); v[4] = bf_lo(a.z); v[5] = bf_hi(a.z); v[6] = bf_lo(a.w); v[7] = bf_hi(a.w);
    v[8] = bf_lo(b.x); v[9] = bf_hi(b.x); v[10] = bf_lo(b.y); v[11] = bf_hi(b.y); v[12] = bf_lo(b.z); v[13] = bf_hi(b.z); v[14] = bf_lo(b.w); v[15] = bf_hi(b.w);
}
__device__ __forceinline__ void load8(const bf16* p, float (&v)[8]) {
    const u32x4 a = *(const GAS u32x4*)p;
    v[0] = bf_lo(a.x); v[1] = bf_hi(a.x); v[2] = bf_lo(a.y); v[3] = bf_hi(a.y); v[4] = bf_lo(a.z); v[5] = bf_hi(a.z); v[6] = bf_lo(a.w); v[7] = bf_hi(a.w);
}

struct SrcPlain {
    const unsigned char* A; const unsigned char* B; int nt, pn0, nu; int sk;
    __device__ __forceinline__ int skew() const { return sk; }
    __device__ __forceinline__ int nseg() const { return nu; }
    __device__ __forceinline__ Seg seg(int u) const { Seg r; r.a = (unsigned long long)A; r.b = (unsigned long long)(B + (size_t)(pn0 + u) * nt * BBLK); r.nsub = 2 * nt; return r; }
};
struct SrcPle {
    const unsigned char* Ap; const unsigned char* Bp; const unsigned char* Ah; const unsigned char* Bg; int sk;
    __device__ __forceinline__ int skew() const { return sk; }
    __device__ __forceinline__ int nseg() const { return 2; }
    __device__ __forceinline__ Seg seg(int k) const { Seg r;
        if (k == 0) { r.a = (unsigned long long)Ap; r.b = (unsigned long long)Bp; r.nsub = 8; }
        else { r.a = (unsigned long long)Ah; r.b = (unsigned long long)Bg; r.nsub = 32; }
        return r; }
};

template <int ACT>
struct PostScale {
    static constexpr int NST = 17;
    LAS unsigned char* lds; bf16* out; int ldo, pm, pn0, nt, tc, u; int mode = 0;
    static __device__ __forceinline__ float act(float x) { if (ACT == 1) { x = fmaxf(x, 0.f); x = x * x; } return x; }
    __device__ __forceinline__ bool due() { if (++tc < nt) return false; tc = 0; return true; }
    __device__ __forceinline__ void run(Acc& acc, int wr, int wc, int fr, int fq) {
        int lr0 = 128 * wr + fr; LAUNDER_V(lr0);
        const int KT = ldo >> 6;
        GAS unsigned char* ob = (GAS unsigned char*)out + eoff(pm, KT, (pn0 + u) * 4 + wc, lr0, fq);
        float rsv[9];
#pragma unroll
        for (int m = 0; m < 8; ++m) rsv[m] = RSTD(lr0 + 16 * m);
        rsv[8] = RSTD(256 + (lr0 & 15));
#pragma unroll
        for (int m = 0; m < 8; ++m) { float v[16];
#pragma unroll
            for (int k = 0; k < 16; ++k) v[k] = act(acc.m[m][k >> 2][k & 3] * rsv[m]);
            store16((bf16*)(ob + (unsigned)(16 * m) * 64u), v); }
        { const int lrx = 256 + (lr0 & 15);
            float v[8];
#pragma unroll
            for (int k = 0; k < 8; ++k) v[k] = act(acc.x[k >> 2][k & 3] * rsv[8]);
            store8((bf16*)((GAS unsigned char*)out + eoff(pm, KT, (pn0 + u) * 4 + wc, lrx, fq) + 16u * (unsigned)wr), v); }
        zero_acc(acc); ++u;
    }
};
struct PostRes {
    static constexpr int NST = 26;
    const bf16* hin; bf16* hout; float* ssq_out; int pm, pn, nt, tc;
    __device__ __forceinline__ bool due() { if (++tc < nt) return false; tc = 0; return true; }
    __device__ __forceinline__ void run(Acc& acc, int wr, int wc, int fr, int fq) {
        int row0 = pm * PR + 128 * wr + fr; LAUNDER_V(row0);
        const int lr0 = row0 - pm * PR;
        const unsigned eb = eoff(pm, 16, pn * 4 + wc, lr0, fq);
        const GAS unsigned char* ib = (const GAS unsigned char*)hin + eb; GAS unsigned char* ob = (GAS unsigned char*)hout + eb;
        float* sq = ssq_out + (unsigned)row0 * NSLOT + 8 * pn + 2 * wc;
        const int rowx = pm * PR + 256 + (lr0 - 128 * wr);
        const unsigned eox = eoff(pm, 16, pn * 4 + wc, 256 + (lr0 - 128 * wr), fq) + 16u * (unsigned)wr;
        u32x4 hv[8][2], hx;
#pragma unroll
        for (int m = 0; m < 6; ++m) { hv[m][0] = *(const GAS u32x4*)(ib + (unsigned)(16 * m) * 64u); hv[m][1] = *(const GAS u32x4*)(ib + (unsigned)(16 * m) * 64u + 16); }
#pragma unroll
        for (int m = 0; m < 8; ++m) { float v[16]; const u32x4 a = hv[m][0], b = hv[m][1];
            if (m == 1) {
#pragma unroll
                for (int m2 = 6; m2 < 8; ++m2) { hv[m2][0] = *(const GAS u32x4*)(ib + (unsigned)(16 * m2) * 64u); hv[m2][1] = *(const GAS u32x4*)(ib + (unsigned)(16 * m2) * 64u + 16); }
                hx = *(const GAS u32x4*)((const GAS unsigned char*)hin + eox);
                __builtin_amdgcn_sched_barrier(0); }
            v[0] = bf_lo(a.x); v[1] = bf_hi(a.x); v[2] = bf_lo(a.y); v[3] = bf_hi(a.y); v[4] = bf_lo(a.z); v[5] = bf_hi(a.z); v[6] = bf_lo(a.w); v[7] = bf_hi(a.w);
            v[8] = bf_lo(b.x); v[9] = bf_hi(b.x); v[10] = bf_lo(b.y); v[11] = bf_hi(b.y); v[12] = bf_lo(b.z); v[13] = bf_hi(b.z); v[14] = bf_lo(b.w); v[15] = bf_hi(b.w);
            float ss = 0.f;
#pragma unroll
            for (int k = 0; k < 16; ++k) { v[k] += acc.m[m][k >> 2][k & 3]; ss += v[k] * v[k]; }
            store16((bf16*)(ob + (unsigned)(16 * m) * 64u), v);
            ss += __shfl_xor(ss, 16); ss += __shfl_xor(ss, 32);
            if (fq == 0) *(GAS f32x2*)(sq + (unsigned)(16 * m) * NSLOT) = (f32x2){ss, 0.f}; }
        { float v[8]; v[0] = bf_lo(hx.x); v[1] = bf_hi(hx.x); v[2] = bf_lo(hx.y); v[3] = bf_hi(hx.y); v[4] = bf_lo(hx.z); v[5] = bf_hi(hx.z); v[6] = bf_lo(hx.w); v[7] = bf_hi(hx.w);
            float ss = 0.f;
#pragma unroll
            for (int k = 0; k < 8; ++k) { v[k] += acc.x[k >> 2][k & 3]; ss += v[k] * v[k]; }
            store8((bf16*)((GAS unsigned char*)hout + eox), v);
            ss += __shfl_xor(ss, 16); ss += __shfl_xor(ss, 32);
            if (fq == 0) ssq_out[(unsigned)rowx * NSLOT + 8 * pn + 2 * wc + wr] = ss; }
        zero_acc(acc);
    }
};
struct PostPle {
    static constexpr int NST = 17;
    LAS unsigned char* lds; const bf16* hin; bf16* hout; float* ssq_out; float* stash; int pm, pn;
    int g = -1, gdue = 0;
    __device__ __forceinline__ bool due() { ++g; if (g != 3 && g != 19) return false; gdue = g; return true; }
    __device__ __forceinline__ void run(Acc& acc, int wr, int wc, int fr, int fq) {
        const int g = gdue;
        int tid = (wr * 4 + wc) * 64 + fq * 16 + fr; LAUNDER_V(tid);
        GAS u32x4* st = (GAS u32x4*)stash + tid;
        if (g == 3) {
#pragma unroll
            for (int m = 0; m < 8; ++m)
#pragma unroll
                for (int hf = 0; hf < 2; ++hf) { u32x4 w; w.x = cvt_pk_bf16(acc.m[m][2 * hf][0], acc.m[m][2 * hf][1]); w.y = cvt_pk_bf16(acc.m[m][2 * hf][2], acc.m[m][2 * hf][3]);
                    w.z = cvt_pk_bf16(acc.m[m][2 * hf + 1][0], acc.m[m][2 * hf + 1][1]); w.w = cvt_pk_bf16(acc.m[m][2 * hf + 1][2], acc.m[m][2 * hf + 1][3]);
                    st[(2 * m + hf) * 512] = w; }
            { u32x4 w; w.x = cvt_pk_bf16(acc.x[0][0], acc.x[0][1]); w.y = cvt_pk_bf16(acc.x[0][2], acc.x[0][3]); w.z = cvt_pk_bf16(acc.x[1][0], acc.x[1][1]); w.w = cvt_pk_bf16(acc.x[1][2], acc.x[1][3]);
              st[16 * 512] = w; }
            zero_acc(acc);
        } else {
            int lr0 = 128 * wr + fr; LAUNDER_V(lr0);
            const int row0 = pm * PR + lr0;
            const unsigned eb = eoff(pm, 16, pn * 4 + wc, lr0, fq);
            const GAS unsigned char* ib = (const GAS unsigned char*)hin + eb; GAS unsigned char* ob = (GAS unsigned char*)hout + eb;
            float* sq = ssq_out + (unsigned)row0 * NSLOT + 8 * pn + 2 * wc;
#pragma unroll
            for (int m = 0; m < 8; ++m) { const int g16 = 16 * m; const float rs = RSTD(lr0 + g16);
                const unsigned o = (unsigned)g16 * 64u;
                float v[16], pp[16];
#pragma unroll
                for (int hf = 0; hf < 2; ++hf) { const u32x4 a = *(const GAS u32x4*)(ib + o + 16 * hf), p = st[(2 * m + hf) * 512];
                    v[8 * hf + 0] = bf_lo(a.x); v[8 * hf + 1] = bf_hi(a.x); v[8 * hf + 2] = bf_lo(a.y); v[8 * hf + 3] = bf_hi(a.y); v[8 * hf + 4] = bf_lo(a.z); v[8 * hf + 5] = bf_hi(a.z); v[8 * hf + 6] = bf_lo(a.w); v[8 * hf + 7] = bf_hi(a.w);
                    pp[8 * hf + 0] = bf_lo(p.x); pp[8 * hf + 1] = bf_hi(p.x); pp[8 * hf + 2] = bf_lo(p.y); pp[8 * hf + 3] = bf_hi(p.y); pp[8 * hf + 4] = bf_lo(p.z); pp[8 * hf + 5] = bf_hi(p.z); pp[8 * hf + 6] = bf_lo(p.w); pp[8 * hf + 7] = bf_hi(p.w); }
                float ss = 0.f;
#pragma unroll
                for (int k = 0; k < 16; ++k) { const float gt = 1.0f / (1.0f + __expf(-acc.m[m][k >> 2][k & 3] * rs)); v[k] += gt * pp[k]; ss += v[k] * v[k]; }
                store16((bf16*)(ob + o), v);
                ss += __shfl_xor(ss, 16); ss += __shfl_xor(ss, 32);
                if (fq == 0) *(GAS f32x2*)(sq + (unsigned)g16 * NSLOT) = (f32x2){ss, 0.f}; }
            { const int lrx = 256 + fr; const int rowx = pm * PR + lrx; const float rs = RSTD(lrx);
                const unsigned eo = eoff(pm, 16, pn * 4 + wc, lrx, fq) + 16u * (unsigned)wr;
                float v[8], pp[8]; load8((const bf16*)((const GAS unsigned char*)hin + eo), v);
                { const u32x4 p = st[16 * 512]; pp[0] = bf_lo(p.x); pp[1] = bf_hi(p.x); pp[2] = bf_lo(p.y); pp[3] = bf_hi(p.y); pp[4] = bf_lo(p.z); pp[5] = bf_hi(p.z); pp[6] = bf_lo(p.w); pp[7] = bf_hi(p.w); }
                float ss = 0.f;
#pragma unroll
                for (int k = 0; k < 8; ++k) { const float gt = 1.0f / (1.0f + __expf(-acc.x[k >> 2][k & 3] * rs)); v[k] += gt * pp[k]; ss += v[k] * v[k]; }
                store8((bf16*)((GAS unsigned char*)hout + eo), v);
                ss += __shfl_xor(ss, 16); ss += __shfl_xor(ss, 32);
                if (fq == 0) ssq_out[(unsigned)rowx * NSLOT + 8 * pn + 2 * wc + wr] = ss; }
        }
    }
};

__device__ __forceinline__ const float* x_row(const float* xp, const float* xs, int R) { const int pm = R / PR, i = R - pm * PR;
    return i < 256 ? xp + (size_t)(256 * pm + i) * D : xs + (size_t)(16 * pm + i - 256) * D; }

__device__ __forceinline__ void transpose64(const float* W, int ldw, const float* gain, bf16* WT, int K, int k0, int n0, LAS float* scr, int lane) {
    const int kr = lane >> 4, nq = lane & 15;
    const GAS float* src = (const GAS float*)W + (size_t)(k0 + kr) * ldw + n0 + 4 * nq;
    f32x4 v[16];
#pragma unroll
    for (int i = 0; i < 16; ++i) v[i] = *(const GAS f32x4*)(src + (size_t)(4 * i) * ldw);
    if (gain) {
#pragma unroll
        for (int i = 0; i < 16; ++i) v[i] = v[i] * gain[k0 + 4 * i + kr];
    }
#pragma unroll
    for (int i = 0; i < 16; ++i) { LAS float* d = scr + (4 * i + kr) * 65 + 4 * nq; d[0] = v[i].x; d[1] = v[i].y; d[2] = v[i].z; d[3] = v[i].w; }
    LGKM_WAIT(); asm volatile("" ::: "memory");
    const int c = lane & 7, nr = lane >> 3;
#pragma unroll
    for (int j = 0; j < 8; ++j) { const int n = nr + 8 * j; const LAS float* s = scr + (8 * c) * 65 + n;
        u32x4 o; o.x = cvt_pk_bf16(s[0 * 65], s[1 * 65]); o.y = cvt_pk_bf16(s[2 * 65], s[3 * 65]); o.z = cvt_pk_bf16(s[4 * 65], s[5 * 65]); o.w = cvt_pk_bf16(s[6 * 65], s[7 * 65]);
        *(GAS u32x4*)(WT + ((size_t)(((n0 + n) >> 8) * (K >> 5) + (k0 >> 5) + (c >> 2)) * 256 + ((n0 + n) & 255)) * 32 + 8 * (c & 3)) = o; }
    LGKM_WAIT(); asm volatile("" ::: "memory");
}

struct MixCtx { const bf16* proj; bf16* mix; const float* state_pool; const float* state_conv; const float* conv_w; const float* conv_b;
                float* npp; float* ncp; float* nps; float* ncs; int layer; };
__device__ __forceinline__ f32x4 ld_bf4(const GAS unsigned char* p) { const u32x2 u = *(const GAS u32x2*)p; return (f32x4){bf_lo(u.x), bf_hi(u.x), bf_lo(u.y), bf_hi(u.y)}; }
__device__ __forceinline__ void st_bf4(GAS unsigned char* p, f32x4 v) { *(GAS u32x2*)p = (u32x2){cvt_pk_bf16(v.x, v.y), cvt_pk_bf16(v.z, v.w)}; }
__device__ __forceinline__ unsigned prow_of(int b, int t) { return (unsigned)((8 * b + (t >> 8)) * PR + (t & 255)); }
__device__ __forceinline__ unsigned pbyte(int b, int t, int col, int KT) { return 2u * ablk(8 * b + (t >> 8), t & 255, col, KT); }

__device__ __forceinline__ void mix_prompt(const MixCtx& M, int pm, int q, int tid) {
    const int b = pm >> 3, layer = M.layer;
    const int role = tid >> 8, rg = (tid >> 7) & 1, c4 = (tid & 127) * 4;
    const int t0 = (pm & 7) * 256 + 64 * q + 32 * rg;
    const GAS unsigned char* pb_ = (const GAS unsigned char*)M.proj; GAS unsigned char* mb_ = (GAS unsigned char*)M.mix;
    if (role == 0) {
        const int W = 2 << (c4 >> 7);
        f32x4 S = {0.f, 0.f, 0.f, 0.f};
#pragma unroll
        for (int j = 1; j < 16; ++j) { const int p = t0 - j; const f32x4 hv_ = ld_bf4(pb_ + pbyte(b, p >= 0 ? p : 0, c4, 32)); if (p >= 0 && j < W) S += hv_; }
        {
            u32x2 ar[32], orr[32];
#pragma unroll
            for (int i = 0; i < 32; ++i) { const int p = t0 + i, po = p - W + 1;
                ar[i] = *(const GAS u32x2*)(pb_ + pbyte(b, p, c4, 32)); orr[i] = *(const GAS u32x2*)(pb_ + pbyte(b, po >= 0 ? po : 0, c4, 32)); }
#pragma unroll
            for (int i = 0; i < 32; ++i) { const int p = t0 + i;
                const f32x4 a = {bf_lo(ar[i].x), bf_hi(ar[i].x), bf_lo(ar[i].y), bf_hi(ar[i].y)}, old = {bf_lo(orr[i].x), bf_hi(orr[i].x), bf_lo(orr[i].y), bf_hi(orr[i].y)};
                S += a;
                const int cnt = (p + 1 < W) ? p + 1 : W;
                st_bf4(mb_ + pbyte(b, p, c4, 16), S * (1.0f / (float)cnt) - a);
                if (p - W + 1 >= 0) S -= old; }
        }
    } else {
        const unsigned co = 2u * (unsigned)c4;
        const f32x4 w0 = *(const GAS f32x4*)(M.conv_w + (size_t)(layer * 3 + 0) * CW + c4), w1 = *(const GAS f32x4*)(M.conv_w + (size_t)(layer * 3 + 1) * CW + c4),
                    w2 = *(const GAS f32x4*)(M.conv_w + (size_t)(layer * 3 + 2) * CW + c4), bias = *(const GAS f32x4*)(M.conv_b + (size_t)layer * CW + c4);
        f32x4 cm2 = {0.f, 0.f, 0.f, 0.f}, cm1 = {0.f, 0.f, 0.f, 0.f};
        if (t0 >= 2) { cm2 = ld_bf4(pb_ + pbyte(b, t0 - 2, 1024 + c4, 32)) * ld_bf4(pb_ + pbyte(b, t0 - 2, 1536 + c4, 32));
                       cm1 = ld_bf4(pb_ + pbyte(b, t0 - 1, 1024 + c4, 32)) * ld_bf4(pb_ + pbyte(b, t0 - 1, 1536 + c4, 32)); }
        {
            u32x2 bgr[32], cgr[32], vr[32];
#pragma unroll
            for (int i = 0; i < 32; ++i) { const int p = t0 + i; bgr[i] = *(const GAS u32x2*)(pb_ + pbyte(b, p, 512 + c4, 32)); cgr[i] = *(const GAS u32x2*)(pb_ + pbyte(b, p, 1024 + c4, 32)); vr[i] = *(const GAS u32x2*)(pb_ + pbyte(b, p, 1536 + c4, 32)); }
#pragma unroll
            for (int i = 0; i < 32; ++i) {
                const f32x4 bg = {bf_lo(bgr[i].x), bf_hi(bgr[i].x), bf_lo(bgr[i].y), bf_hi(bgr[i].y)};
                const f32x4 cc = (f32x4){bf_lo(cgr[i].x), bf_hi(cgr[i].x), bf_lo(cgr[i].y), bf_hi(cgr[i].y)} * (f32x4){bf_lo(vr[i].x), bf_hi(vr[i].x), bf_lo(vr[i].y), bf_hi(vr[i].y)};
                const f32x4 z = bias + w0 * cm2 + w1 * cm1 + w2 * cc;
                st_bf4(mb_ + pbyte(b, t0 + i, 512 + c4, 16), bg * z);
                cm2 = cm1; cm1 = cc; }
        }
    }
    if ((pm & 7) == 7 && q == 3) {
        if (tid < 128) {
#pragma unroll 1
            for (int i = 0; i < 15; ++i) *(GAS f32x4*)(M.npp + ((size_t)(layer * NB + b) * 15 + i) * PW + c4) = ld_bf4(pb_ + pbyte(b, SEQ - 15 + i, c4, 32));
        } else if (tid >= 256 && tid < 384) {
#pragma unroll 1
            for (int i = 0; i < 2; ++i)
                *(GAS f32x4*)(M.ncp + ((size_t)(layer * NB + b) * 2 + i) * CW + c4) = ld_bf4(pb_ + pbyte(b, SEQ - 2 + i, 1024 + c4, 32)) * ld_bf4(pb_ + pbyte(b, SEQ - 2 + i, 1536 + c4, 32));
        }
    }
}
__device__ __forceinline__ void mix_sample(const MixCtx& M, int pm, int q, int tid) {
    const int sb = 2 * pm + q, layer = M.layer, c4 = (tid & 127) * 4, L0 = 256 + 8 * q;
    const GAS unsigned char* pb_ = (const GAS unsigned char*)M.proj; GAS unsigned char* mb_ = (GAS unsigned char*)M.mix;
    if (tid < 128) {
        const int W = 2 << (c4 >> 7);
        const float* sp = M.state_pool + (size_t)(layer * DB + sb) * 15 * PW + c4;
        float* nps = M.nps + (size_t)(layer * DB + sb) * 15 * PW + c4;
        f32x4 S = {0.f, 0.f, 0.f, 0.f};
#pragma unroll 1
        for (int j = 1; j < W; ++j) S += *(const GAS f32x4*)(sp + (size_t)(15 - j) * PW);
#pragma unroll 1
        for (int r = 0; r < 8; ++r) {
            const f32x4 a = ld_bf4(pb_ + 2u * ablk(pm, L0 + r, c4, 32));
            const int po = r - W + 1;
            f32x4 old; if (po >= 0) old = ld_bf4(pb_ + 2u * ablk(pm, L0 + po, c4, 32)); else old = *(const GAS f32x4*)(sp + (size_t)(15 + po) * PW);
            S += a;
            st_bf4(mb_ + 2u * ablk(pm, L0 + r, c4, 16), S * (1.0f / (float)W) - a);
            *(GAS f32x4*)(nps + (size_t)(7 + r) * PW) = a;
            S -= old; }
#pragma unroll 1
        for (int i = 0; i < 7; ++i) *(GAS f32x4*)(nps + (size_t)i * PW) = *(const GAS f32x4*)(sp + (size_t)(8 + i) * PW);
    } else if (tid >= 256 && tid < 384) {
        const float* sc = M.state_conv + (size_t)(layer * DB + sb) * 2 * CW + c4;
        const f32x4 w0 = *(const GAS f32x4*)(M.conv_w + (size_t)(layer * 3 + 0) * CW + c4), w1 = *(const GAS f32x4*)(M.conv_w + (size_t)(layer * 3 + 1) * CW + c4),
                    w2 = *(const GAS f32x4*)(M.conv_w + (size_t)(layer * 3 + 2) * CW + c4), bias = *(const GAS f32x4*)(M.conv_b + (size_t)layer * CW + c4);
        f32x4 cm2 = *(const GAS f32x4*)sc, cm1 = *(const GAS f32x4*)(sc + CW);
#pragma unroll 1
        for (int r = 0; r < 8; ++r) {
            const f32x4 bg = ld_bf4(pb_ + 2u * ablk(pm, L0 + r, 512 + c4, 32)), cc = ld_bf4(pb_ + 2u * ablk(pm, L0 + r, 1024 + c4, 32)) * ld_bf4(pb_ + 2u * ablk(pm, L0 + r, 1536 + c4, 32));
            const f32x4 z = bias + w0 * cm2 + w1 * cm1 + w2 * cc;
            st_bf4(mb_ + 2u * ablk(pm, L0 + r, 512 + c4, 16), bg * z);
            if (r >= 6) *(GAS f32x4*)(M.ncs + ((size_t)(layer * DB + sb) * 2 + (r - 6)) * CW + c4) = cc;
            cm2 = cm1; cm1 = cc; }
    }
}

__global__ void __launch_bounds__(512) fwd_kernel(Args args) {
    extern __shared__ __attribute__((aligned(16))) unsigned char lds_raw[];
    LAS unsigned char* lds = (LAS unsigned char*)lds_raw;
    const int tid = threadIdx.x, lane = tid & 63, wave = __builtin_amdgcn_readfirstlane(tid >> 6);
    const int G = gridDim.x, bx = blockIdx.x, vcu = (G % 8 == 0) ? (bx % 8) * (G / 8) + bx / 8 : bx;
    const int pm_ = vcu >> 2, q_ = vcu & 3;
    unsigned char* ws = args.ws;
    const int lo = args.ph_lo, hi = args.ph_hi;

    volatile LAS unsigned* MISC = (volatile LAS unsigned*)(lds + MISC_OFF);
    if (tid < 64) MISC[tid] = 0u;
    __syncthreads();
    XcdBarrier bar; bar.bar = (unsigned*)(ws + WS_CTL); bar.x = 0; bar.st = MISC;
    if (hi - lo > 1) bar = xcd_barrier_post((unsigned*)(ws + WS_CTL), MISC);
#ifndef PH_EN
#define PH_EN 0x7fff
#endif
#define LY_EN(i) ((PH_EN >> (2 + (i))) & 1)
#define IN(k) (lo <= (k) && (k) < hi)
#define SEAM(k) do { if (IN(k) && IN((k) + 1)) xcd_barrier(bar); } while (0)

    const float* x_prompt = args.in[0]; const float* x_sample = args.in[1]; const float* state_pool = args.in[2]; const float* state_conv = args.in[3];
    const float* p_prompt = args.in[4]; const float* p_sample = args.in[5]; const float* norm_mix = args.in[6]; const float* w_in = args.in[7];
    const float* pool_w = args.in[8]; const float* pool_scale = args.in[9]; const float* conv_w = args.in[10]; const float* conv_b = args.in[11];
    const float* w_out = args.in[12]; const float* norm_mlp = args.in[13]; const float* w_up = args.in[14]; const float* w_down = args.in[15];
    const float* norm_ple = args.in[16]; const float* w_ple_gate = args.in[17]; const float* w_ple_proj = args.in[18]; const float* norm_f = args.in[19];
    float* out = args.out;
    float* ssq0 = (float*)(ws + WS_SSQ0); float* ssq1 = (float*)(ws + WS_SSQ1);
    float* fold = (float*)(ws + WS_FOLD);
    bf16* hA = (bf16*)(ws + WS_HA); bf16* hB = (bf16*)(ws + WS_R + R_HB);
    bf16* pb = (bf16*)(ws + WS_PB);
    bf16* proj = (bf16*)(ws + WS_R + R_PROJ); bf16* mixA = (bf16*)(ws + WS_R + R_MIX); bf16* fbuf = (bf16*)(ws + WS_R + R_F);
    float* stash = (float*)(ws + WS_R + R_STASH) + (size_t)bx * (PR * 256);
    const int gw = vcu * 8 + wave, NGW = G * 8;
    unsigned long long stall = 0;

#if PROBE_STORE
    { unsigned char* dst = ws + WS_R;
      const int fr_ = lane & 15, fq_ = lane >> 4, wr_ = wave >> 2, wc_ = wave & 3;
      const u32x4 val = {(unsigned)tid, 1u, 2u, 3u};
      for (int rnd = 0; rnd < 8; ++rnd) {
        for (int m = 0; m < 8; ++m) {
          const unsigned row = (unsigned)(pm_ * PR + 128 * wr_ + 16 * m), colb = (unsigned)((4 * q_ + (rnd & 3)) * 512 + 128 * wc_);
          if (PROBE_STORE == 2) { const unsigned r0 = row + (lane >> 3), cb_ = colb + 16 * (lane & 7);
            *(GAS u32x4*)(dst + (size_t)r0 * 8192 + cb_) = val; *(GAS u32x4*)(dst + (size_t)(r0 + 8) * 8192 + cb_) = val; }
          else if (PROBE_STORE == 3) { GAS u32x4* p_ = (GAS u32x4*)(dst + (size_t)(row + fr_) * 8192 + colb + 32 * fq_); __builtin_nontemporal_store(val, p_); __builtin_nontemporal_store(val, p_ + 1); }
          else { GAS u32x4* p_ = (GAS u32x4*)(dst + (size_t)(row + fr_) * 8192 + colb + 32 * fq_); p_[0] = val; p_[1] = val; }
        }
        asm volatile("s_waitcnt vmcnt(0)" ::: "memory"); __syncthreads();
      } }
#endif
#if PROBE_MFMAONLY
    if (PROBE_MFMAONLY == 1 || wave < 4) { f32x4 d_[8]; bf16x8 a_, b_;
#pragma unroll
      for (int i = 0; i < 8; ++i) d_[i] = (f32x4){0.f, 0.f, 0.f, 0.f};
#pragma unroll
      for (int i = 0; i < 8; ++i) { a_[i] = (short)(tid + i); b_[i] = (short)(lane * 3 + i); }
#pragma unroll 1
      for (int it = 0; it < 64 * 68 / 8; ++it) {
#pragma unroll
          for (int i = 0; i < 8; ++i) d_[i] = __builtin_amdgcn_mfma_f32_16x16x32_bf16(a_, b_, d_[i], 0, 0, 0);
      }
      asm volatile("" :: "v"(d_[0]), "v"(d_[1]), "v"(d_[2]), "v"(d_[3]), "v"(d_[4]), "v"(d_[5]), "v"(d_[6]), "v"(d_[7])); }
    __syncthreads();
#endif
    for (int rep = 0; rep < 1 + (PROBE_PH == 6 ? PROBE_REPS : 0); ++rep) {
    if (rep) xcd_barrier(bar);
    if ((PH_EN & 1) && IN(0)) {
        for (int R = 4 * gw; R < MT; R += 4 * NGW) {
            f32x4 v[4][4];
#pragma unroll
            for (int r = 0; r < 4; ++r) { const GAS f32x4* xr = (const GAS f32x4*)x_row(x_prompt, x_sample, R + r) + lane;
#pragma unroll
                for (int j = 0; j < 4; ++j) v[r][j] = xr[64 * j]; }
#pragma unroll
            for (int r = 0; r < 4; ++r) { float s = 0.f;
#pragma unroll
                for (int j = 0; j < 4; ++j) s += (v[r][j].x * v[r][j].x + v[r][j].y * v[r][j].y) + (v[r][j].z * v[r][j].z + v[r][j].w * v[r][j].w);
                s = wave_sum(s);
                const int pmr = (R + r) / PR, lrr = (R + r) - pmr * PR;
#pragma unroll
                for (int j = 0; j < 4; ++j) *(GAS u32x2*)(hA + ablk(pmr, lrr, 4 * (lane + 64 * j), 16)) = (u32x2){cvt_pk_bf16(v[r][j].x, v[r][j].y), cvt_pk_bf16(v[r][j].z, v[r][j].w)};
                if (lane < NSLOT) ssq0[(size_t)(R + r) * NSLOT + lane] = (lane == 0) ? s : 0.f; }
        }
        for (int i0 = 8 * gw; i0 < 2 * MT; i0 += 8 * NGW) {
            f32x4 v[8];
#pragma unroll
            for (int r = 0; r < 8; ++r) { const int idx = i0 + r; const int l = idx / MT, R = idx - l * MT, pmr = R / PR, i = R - pmr * PR;
                const float* sp = i < 256 ? p_prompt + ((size_t)l * MP + 256 * pmr + i) * PLE : p_sample + ((size_t)l * MS + 16 * pmr + i - 256) * PLE;
                v[r] = ((const GAS f32x4*)sp)[lane]; }
#pragma unroll
            for (int r = 0; r < 8; ++r) { const int idx = i0 + r; const int l = idx / MT, R = idx - l * MT, pmr = R / PR, lrr = R - pmr * PR;
                *(GAS u32x2*)(pb + (size_t)l * MT * PLE + ablk(pmr, lrr, 4 * lane, 4)) = (u32x2){cvt_pk_bf16(v[r].x, v[r].y), cvt_pk_bf16(v[r].z, v[r].w)}; }
        }
        {
            LAS float* scr = (LAS float*)(lds + wave * 16640);
            constexpr int I_IN = 16 * 32, I_OUT = 8 * 16, I_UP = 16 * 64, I_DN = 64 * 16, I_G = 16 * 16, I_P = 4 * 16, I_L = I_IN + I_OUT + I_UP + I_DN + I_G + I_P;
            for (int it = gw; it < DEPTH * I_L; it += NGW) {
                const int l = it / I_L; int r = it - l * I_L; unsigned char* wl = ws + WS_W + (size_t)l * W_LAYER;
                if (r < I_IN) { const int kb = r / 32, nb = r % 32; transpose64(w_in + (size_t)l * D * INC, INC, norm_mix + l * D, (bf16*)(wl + W_IN), D, 64 * kb, 64 * nb, scr, lane); continue; } r -= I_IN;
                if (r < I_OUT) { const int kb = 8 + r / 16, nb = r % 16; transpose64(w_out + (size_t)l * D * D, D, nullptr, (bf16*)(wl + W_OUT), D, 64 * kb, 64 * nb, scr, lane); continue; } r -= I_OUT;
                if (r < I_UP) { const int kb = r / 64, nb = r % 64; transpose64(w_up + (size_t)l * D * DFF, DFF, norm_mlp + l * D, (bf16*)(wl + W_UP), D, 64 * kb, 64 * nb, scr, lane); continue; } r -= I_UP;
                if (r < I_DN) { const int kb = r / 16, nb = r % 16; transpose64(w_down + (size_t)l * DFF * D, D, nullptr, (bf16*)(wl + W_DN), DFF, 64 * kb, 64 * nb, scr, lane); continue; } r -= I_DN;
                if (r < I_G) { const int kb = r / 16, nb = r % 16; transpose64(w_ple_gate + (size_t)l * D * D, D, norm_ple + l * D, (bf16*)(wl + W_G), D, 64 * kb, 64 * nb, scr, lane); continue; } r -= I_G;
                { const int kb = r / 16, nb = r % 16; transpose64(w_ple_proj + (size_t)l * PLE * D, D, nullptr, (bf16*)(wl + W_P), PLE, 64 * kb, 64 * nb, scr, lane); }
            }
        }
        for (int it = gw; it < DEPTH * 4 * 64 * 4; it += NGW) {
            const int nb = it & 3, k2 = (it >> 2) & 63, g = (it >> 8) & 3, l = it >> 10;
            const float* pw0 = pool_w + ((size_t)(l * 4 + g) * 128 + 2 * k2) * 128; const float* sc = pool_scale + l * PW + 128 * g;
            const GAS f32x4* wo = (const GAS f32x4*)(w_out + ((size_t)l * D + 128 * g) * D + 256 * nb) + lane;
            f32x4 a0 = {0.f, 0.f, 0.f, 0.f}, a1 = {0.f, 0.f, 0.f, 0.f};
#pragma unroll 8
            for (int c = 0; c < 128; ++c) { const f32x4 w = wo[(size_t)c * (D / 4)] * sc[c]; a0 += w * pw0[c]; a1 += w * pw0[128 + c]; }
            GAS f32x4* fo = (GAS f32x4*)(fold + ((size_t)l * 512 + 128 * g + 2 * k2) * D + 256 * nb) + lane;
            fo[0] = a0; fo[D / 4] = a1;
        }
        __syncthreads();
    } }
    SEAM(1);
    if (PROBE_PH == 8) for (int rep = 0; rep < PROBE_REPS; ++rep) xcd_barrier(bar);

    if ((PH_EN & 2) && IN(2)) {
        if (wave == 7) { int vc = vcu; LAUNDER_S(vc); const int ly = vc >> 7, r = vc & 127, kb = r >> 4, nb = r & 15;
            transpose64((const float*)(ws + WS_FOLD) + (size_t)ly * 512 * D, D, nullptr, (bf16*)(ws + WS_W + (size_t)ly * W_LAYER + W_OUT), D, 64 * kb, 64 * nb, (LAS float*)(lds + RSTD_OFF + 1280), lane); }
    }
#pragma unroll 1
    for (int l = 0; l < DEPTH; ++l) {
        const int p0 = 2 + 6 * l;
        int pm = pm_; int q = q_;
        const unsigned char* wl = ws + WS_W + (size_t)l * W_LAYER;
        const bf16* hin = (l == 0) ? hA : hB;
        float* ssA = (l == 0) ? ssq0 : ssq1;
        float* ssB = (l == 0) ? ssq1 : ssq0;
        for (int rep = 0; rep < 1 + (PROBE_PH == 0 ? PROBE_REPS : 0); ++rep) {
        if (rep) xcd_barrier(bar);
        if (LY_EN(0) && IN(p0 + 0)) { LAUNDER_S(pm); LAUNDER_S(q);
            SrcPlain S{(const unsigned char*)(hin + (size_t)pm * PR * D), wl + W_IN, 16, 2 * q, 2, ((pm & 7) + 2 * q) & 7};
            panel_rstd(lds, ssA, pm, tid);
            PostScale<0> P{lds, proj, INC, pm, 2 * q, 16, 0, 0};
            gemm_stream(lds, S, P, 32, wave, lane, stall);
        } }
        SEAM(p0 + 0);
        for (int rep = 0; rep < 1 + (PROBE_PH == 1 ? PROBE_REPS : 0); ++rep) {
        if (rep) xcd_barrier(bar);
        if (LY_EN(1) && IN(p0 + 1)) { LAUNDER_S(pm); LAUNDER_S(q);
            MixCtx M{proj, mixA, state_pool, state_conv, conv_w, conv_b, out + O_NPP, out + O_NCP, out + O_NPS, out + O_NCS, l};
            int tidm = tid; LAUNDER_V(tidm);
            mix_prompt(M, pm, q, tidm);
            if (q < 2) mix_sample(M, pm, q, tidm);
        } }
        SEAM(p0 + 1);
        for (int rep = (PROBE_PH == 2 ? PROBE_REPS : 0); rep >= 0; --rep) {
        if (LY_EN(2) && IN(p0 + 2)) { LAUNDER_S(pm); LAUNDER_S(q);
            SrcPlain S{(const unsigned char*)(mixA + (size_t)pm * PR * D), wl + W_OUT, 16, q, 1, ((pm & 7) + 2 * q) & 7};
            PostRes P{hin, rep ? (bf16*)out : hA, rep ? (float*)out + 9000000 : ssB, pm, q, 16, 0};
            gemm_stream(lds, S, P, 16, wave, lane, stall);
        }
        if (rep) xcd_barrier(bar); }
        SEAM(p0 + 2);
        for (int rep = 0; rep < 1 + (PROBE_PH == 3 ? PROBE_REPS : 0); ++rep) {
        if (rep) xcd_barrier(bar);
        if (LY_EN(3) && IN(p0 + 3)) { LAUNDER_S(pm); LAUNDER_S(q);
            SrcPlain S{(const unsigned char*)(hA + (size_t)pm * PR * D), wl + W_UP, 16, 4 * q, 4, ((pm & 7) + 2 * q) & 7};
            panel_rstd(lds, ssB, pm, tid);
            PostScale<1> P{lds, fbuf, DFF, pm, 4 * q, 16, 0, 0};
            if (rep == 0) gemm_stream(lds, S, P, 64, wave, lane, stall); else gemm_stream<(PROBE_DRY == 5) ? 0 : PROBE_DRY>(lds, S, P, 64, wave, lane, stall);
        } }
        SEAM(p0 + 3);
        for (int rep = (PROBE_PH == 4 ? PROBE_REPS : 0); rep >= 0; --rep) {
        if (LY_EN(4) && IN(p0 + 4)) { LAUNDER_S(pm); LAUNDER_S(q);
            SrcPlain S{(const unsigned char*)(fbuf + (size_t)pm * PR * DFF), wl + W_DN, 64, q, 1, ((pm & 7) + 2 * q) & 7};
            PostRes P{hA, rep ? (bf16*)out : hA, rep ? (float*)out + 9000000 : ssA, pm, q, 64, 0};
            gemm_stream(lds, S, P, 64, wave, lane, stall);
        }
        if (rep) xcd_barrier(bar); }
        SEAM(p0 + 4);
        for (int rep = 0; rep < 1 + (PROBE_PH == 5 ? PROBE_REPS : 0); ++rep) {
        if (rep) xcd_barrier(bar);
        if (LY_EN(5) && IN(p0 + 5)) { LAUNDER_S(pm); LAUNDER_S(q);
            SrcPle S{(const unsigned char*)(pb + ((size_t)l * MT + (size_t)pm * PR) * PLE), wl + W_P + (size_t)q * 4 * BBLK,
                     (const unsigned char*)(hA + (size_t)pm * PR * D), wl + W_G + (size_t)q * 16 * BBLK, ((pm & 7) + 2 * q) & 7};
            panel_rstd(lds, ssA, pm, tid);
            PostPle P{lds, hA, hB, ssB, stash, pm, q};
            gemm_stream(lds, S, P, 20, wave, lane, stall);
        } }
        SEAM(p0 + 5);
    }
    for (int rep = 0; rep < 1 + (PROBE_PH == 7 ? PROBE_REPS : 0); ++rep) {
    if (rep) xcd_barrier(bar);
    if ((PH_EN & 0x4000) && IN(14)) {
        f32x4 gv[4];
#pragma unroll
        for (int j = 0; j < 4; ++j) gv[j] = ((const GAS f32x4*)norm_f)[lane * 2 + (j & 1) + 128 * (j >> 1)];
        {
            u32x4 ha[9], hbq[9];
#pragma unroll
            for (int k = 0; k < 9; ++k) { int R = gw + k * NGW; R = R < MT ? R : MT - 1; const int pmr = R / PR, i = R - pmr * PR;
                ha[k] = *(const GAS u32x4*)(hB + ablk(pmr, i, 8 * lane, 16)); hbq[k] = *(const GAS u32x4*)(hB + ablk(pmr, i, 512 + 8 * lane, 16)); }
#pragma unroll
            for (int k = 0; k < 9; ++k) { const int R = gw + k * NGW;
                const u32x4 a = ha[k], b = hbq[k];
                float v[16] = {bf_lo(a.x), bf_hi(a.x), bf_lo(a.y), bf_hi(a.y), bf_lo(a.z), bf_hi(a.z), bf_lo(a.w), bf_hi(a.w),
                               bf_lo(b.x), bf_hi(b.x), bf_lo(b.y), bf_hi(b.y), bf_lo(b.z), bf_hi(b.z), bf_lo(b.w), bf_hi(b.w)};
                float s = 0.f;
#pragma unroll
                for (int kk = 0; kk < 16; ++kk) s += v[kk] * v[kk];
                s = wave_sum(s);
                const float rs = __builtin_amdgcn_rsqf(s * (1.0f / D) + EPS);
                if (R < MT) { const int pmr = R / PR, i = R - pmr * PR;
                    float* dst = i < 256 ? out + O_YP + (size_t)(256 * pmr + i) * D : out + O_YS + (size_t)(16 * pmr + i - 256) * D;
                    GAS f32x4* o = (GAS f32x4*)dst;
                    o[lane * 2 + 0] = (f32x4){v[0] * rs * gv[0].x, v[1] * rs * gv[0].y, v[2] * rs * gv[0].z, v[3] * rs * gv[0].w};
                    o[lane * 2 + 1] = (f32x4){v[4] * rs * gv[1].x, v[5] * rs * gv[1].y, v[6] * rs * gv[1].z, v[7] * rs * gv[1].w};
                    o[128 + lane * 2 + 0] = (f32x4){v[8] * rs * gv[2].x, v[9] * rs * gv[2].y, v[10] * rs * gv[2].z, v[11] * rs * gv[2].w};
                    o[128 + lane * 2 + 1] = (f32x4){v[12] * rs * gv[3].x, v[13] * rs * gv[3].y, v[14] * rs * gv[3].z, v[15] * rs * gv[3].w}; }
            }
        }
    } }
#if PROBE_XCC
    { unsigned* xw = (unsigned*)(ws + WS_CTL + 40960);
      if (tid == 0) { const unsigned me = xb_xcc_id() + 1u; const unsigned old_ = atomicCAS(xw + (bx & 7), 0u, me); if (old_ != 0u && old_ != me) atomicAdd(xw + 8, 1u); }
      xcd_barrier(bar);
      if (bx == 0 && wave == 0) { const unsigned bad = __hip_atomic_load(xw + 8, __ATOMIC_RELAXED, __HIP_MEMORY_SCOPE_AGENT);
        if (bad) { const unsigned long long t0_ = rstamp(); while (rstamp() - t0_ < 40000ull) __builtin_amdgcn_s_sleep(8); } } }
#endif
#if PROBE_STALL >= 11
    if (bx == 0 && wave == ((PROBE_STALL == 12) ? 4 : 0)) { const unsigned long long t0_ = rstamp(); while (rstamp() - t0_ < stall) __builtin_amdgcn_s_sleep(8); }
#elif PROBE_STALL >= 9
    if (bx == 0 && wave == 0) { const unsigned long long tgt = (PROBE_STALL == 9) ? stall : stall / 24; const unsigned long long t0_ = rstamp(); while (rstamp() - t0_ < tgt) __builtin_amdgcn_s_sleep(8); }
#elif PROBE_STALL >= 6 && PROBE_STALL <= 8
    { unsigned long long* red = (unsigned long long*)(ws + WS_CTL + 32768);
      if (lane == 0 && wave == ((PROBE_STALL == 8) ? 4 : 0)) { if (PROBE_STALL == 7) atomicMax(red, ~stall); else atomicMax(red, stall); }
      xcd_barrier(bar);
      if (bx == 0 && wave == 0) { unsigned long long tgt = __hip_atomic_load(red, __ATOMIC_RELAXED, __HIP_MEMORY_SCOPE_AGENT); if (PROBE_STALL == 7) tgt = ~tgt;
        const unsigned long long t0_ = tstamp(); while (tstamp() - t0_ < tgt) __builtin_amdgcn_s_sleep(8); } }
#elif PROBE_STALL
    if (bx == 0 && wave == 0) { const unsigned long long t0_ = tstamp(); while (tstamp() - t0_ < stall) __builtin_amdgcn_s_sleep(8); }
#endif
#undef IN
#undef SEAM
}

extern "C" void kernel_launch(void* const* d_in, const int* in_sizes, int n_in, void* d_out, int out_size, void* d_ws, size_t ws_size, hipStream_t stream) {
    static int ready = 0;
    if (ready == 0) {
        if (n_in != 20 || out_size != (int)O_END || ws_size < WS_END) { fprintf(stderr, "kernel_launch: unexpected shapes (n_in %d out %d ws %zu)\n", n_in, out_size, ws_size); ready = -1; return; }
        if (hipFuncSetAttribute((const void*)fwd_kernel, hipFuncAttributeMaxDynamicSharedMemorySize, LDS_BYTES) != hipSuccess) { fprintf(stderr, "kernel_launch: hipFuncSetAttribute failed\n"); ready = -1; return; }
        ready = 1;
    }
    if (ready < 0) return;
    (void)in_sizes;
    (void)hipMemsetAsync((char*)d_ws + WS_CTL, 0, CTL_BYTES, stream);
    Args a{};
    for (int i = 0; i < 20; ++i) a.in[i] = (const float*)d_in[i];
    a.out = (float*)d_out; a.ws = (unsigned char*)d_ws;
#if N_LAUNCH_MODE == 1
    a.ph_lo = 0; a.ph_hi = NPHASE;
    hipLaunchKernelGGL(fwd_kernel, dim3(256), dim3(512), LDS_BYTES, stream, a);
#else
    for (int p = 0; p < NPHASE; ++p) { a.ph_lo = p; a.ph_hi = p + 1; hipLaunchKernelGGL(fwd_kernel, dim3(256), dim3(512), LDS_BYTES, stream, a); }
#endif
}
```
